# Optimizing an MI355X kernel written in HIP

```python
import math
import jax, jax.numpy as jnp
from jax import lax
import numpy as np

D_MODEL = 1024
BATCH = 32
SEQ = 256
DEPTH = 2
DEC_BATCH = 8
DEC_SEQ = 4096
PAST_LEN = 512

GRID_W = 64
HEAD_DIM = 64
MIX_WIDTH = D_MODEL
GROUP_WIDTH = MIX_WIDTH // 4
N_HEADS_A = GROUP_WIDTH // HEAD_DIM
KV_HEADS_A = 2
Q_PER_KV = N_HEADS_A // KV_HEADS_A
N_HEADS_C = GROUP_WIDTH // HEAD_DIM
N_FOURIER_GROUPS = GROUP_WIDTH // HEAD_DIM
FOURIER_GROUP_DIM = HEAD_DIM
SHORT_CONV = 3
DELTA_CHUNK = 64
Q_BLOCK = 128
ROPE_THETA = 10000.0
D_FF = 2816
N_MOD = 9
EPS = 1e-6
SPLIT_SIZES = (N_HEADS_A * HEAD_DIM, KV_HEADS_A * HEAD_DIM, KV_HEADS_A * HEAD_DIM,
               GROUP_WIDTH, GROUP_WIDTH, GROUP_WIDTH,
               GROUP_WIDTH, GROUP_WIDTH, GROUP_WIDTH, GROUP_WIDTH,
               N_HEADS_C, N_HEADS_C, N_HEADS_C, N_HEADS_C,
               GROUP_WIDTH)
PROJ_WIDTH = sum(SPLIT_SIZES)

kernel_name = 'hybrid_diffusion_parallel_groups_step'


def split_cols(t):
    offs = [int(o) for o in np.cumsum(SPLIT_SIZES)[:-1]]
    return jnp.split(t, offs, axis=-1)


def rms_norm(x, g):
    x32 = x.astype(jnp.float32)
    y = x32 * lax.rsqrt(jnp.mean(x32 * x32, axis=-1, keepdims=True) + EPS)
    return (y * g.astype(jnp.float32)).astype(x.dtype)


def l2_norm(x):
    return x * lax.rsqrt(jnp.sum(x * x, axis=-1, keepdims=True) + EPS)


def rope_2d(x):
    L = x.shape[1]
    rows = L // GRID_W
    r, cl = jnp.meshgrid(jnp.arange(rows), jnp.arange(GRID_W), indexing='ij')
    pos_r = r.reshape(-1).astype(jnp.float32)
    pos_c = cl.reshape(-1).astype(jnp.float32)
    quarter = HEAD_DIM // 4
    half = HEAD_DIM // 2
    inv_freq = ROPE_THETA ** (-jnp.arange(quarter, dtype=jnp.float32) / quarter)

    def rot(xh, pos):
        ang = pos[:, None] * inv_freq[None, :]
        cos = jnp.cos(ang)[None, :, None, :].astype(x.dtype)
        sin = jnp.sin(ang)[None, :, None, :].astype(x.dtype)
        x1, x2 = xh[..., :quarter], xh[..., quarter:]
        return jnp.concatenate([x1 * cos - x2 * sin, x2 * cos + x1 * sin], axis=-1)

    return jnp.concatenate([rot(x[..., :half], pos_r), rot(x[..., half:], pos_c)], axis=-1)


def block_attention(q, k, v):
    Bn, Lq = q.shape[0], q.shape[1]
    nb = Lq // Q_BLOCK
    qb = jnp.moveaxis(q.reshape(Bn, nb, Q_BLOCK, KV_HEADS_A, Q_PER_KV, HEAD_DIM), 1, 0)
    scale = HEAD_DIM ** -0.5

    def one_block(qi):
        s = jnp.einsum('bqhgd,bkhd->bhgqk', qi, k).astype(jnp.float32) * scale
        p = jax.nn.softmax(s, axis=-1).astype(v.dtype)
        return jnp.einsum('bhgqk,bkhd->bqhgd', p, v)

    o = lax.map(one_block, qb)
    return jnp.moveaxis(o, 0, 1).reshape(Bn, Lq, N_HEADS_A * HEAD_DIM)


def depthwise_conv(u, w):
    K = w.shape[0]
    pad = K // 2
    L = u.shape[1]
    up = jnp.pad(u, ((0, 0), (pad, pad), (0, 0)))
    y = up[:, 0:L] * w[0]
    for j in range(1, K):
        y = y + up[:, j:j + L] * w[j]
    return y


def chunk_gated_delta(q, k, v, g, beta, s0):
    Bn, H, L, dk = q.shape
    dv = v.shape[-1]
    C = DELTA_CHUNK
    n = L // C
    q = q.reshape(Bn, H, n, C, dk)
    k = k.reshape(Bn, H, n, C, dk)
    v = v.reshape(Bn, H, n, C, dv)
    g = g.reshape(Bn, H, n, C)
    beta = beta.reshape(Bn, H, n, C)
    gc = jnp.cumsum(g, axis=-1)
    idx = jnp.arange(C)
    incl = idx[:, None] >= idx[None, :]
    strict = idx[:, None] > idx[None, :]
    decay = jnp.exp(jnp.where(incl, gc[..., :, None] - gc[..., None, :], -jnp.inf))
    kb = k * beta[..., None]
    vb = v * beta[..., None]
    lmat = jnp.where(strict, jnp.einsum('bhncd,bhnjd->bhncj', kb, k) * decay, 0.0)
    eye = jnp.eye(C, dtype=jnp.float32)
    t_inv = lax.linalg.triangular_solve(eye + lmat, jnp.broadcast_to(eye, lmat.shape),
                                        left_side=True, lower=True, unit_diagonal=True)
    u = t_inv @ vb
    w = t_inv @ (kb * jnp.exp(gc)[..., None])
    aqk = jnp.einsum('bhncd,bhnjd->bhncj', q, k) * decay
    qg = q * jnp.exp(gc)[..., None]
    kdec = k * jnp.exp(gc[..., -1:] - gc)[..., None]
    glast = jnp.exp(gc[..., -1])

    def step(S, xs):
        u_c, w_c, qg_c, aqk_c, kdec_c, gl = xs
        v_new = u_c - w_c @ S
        o_c = qg_c @ S + aqk_c @ v_new
        S = S * gl[..., None, None] + jnp.swapaxes(kdec_c, -1, -2) @ v_new
        return S, o_c

    xs = tuple(jnp.moveaxis(a, 2, 0) for a in (u, w, qg, aqk, kdec, glast))
    S, o = lax.scan(step, s0, xs)
    o = jnp.moveaxis(o, 0, 2).reshape(Bn, H, L, dv)
    return o, S


def gated_deltanet(qc, kc, vc, zc, beta_f, beta_b, a_f, a_b, conv_w, a_log, dt_bias, norm_g, s0):
    f32 = jnp.float32
    Bn, L, _ = qc.shape
    qkv = jax.nn.silu(depthwise_conv(jnp.concatenate([qc, kc, vc], axis=-1), conv_w).astype(f32))
    q, k, v = jnp.split(qkv, 3, axis=-1)

    def heads(t):
        return jnp.swapaxes(t.reshape(Bn, L, N_HEADS_C, HEAD_DIM), 1, 2)

    q = l2_norm(heads(q)) * HEAD_DIM ** -0.5
    k = l2_norm(heads(k))
    v = heads(v)
    decay_rate = jnp.exp(a_log.astype(f32))
    dtb = dt_bias.astype(f32)

    def gates(b_raw, a_raw, d):
        beta = jax.nn.sigmoid(b_raw.astype(f32))
        g = -decay_rate[d] * jax.nn.softplus(a_raw.astype(f32) + dtb[d])
        return jnp.swapaxes(beta, 1, 2), jnp.swapaxes(g, 1, 2)

    bf, gf = gates(beta_f, a_f, 0)
    bb, gb = gates(beta_b, a_b, 1)
    s0 = s0.astype(f32)
    o_f, s_f = chunk_gated_delta(q, k, v, gf, bf, s0[:, 0])

    def rev(t):
        return jnp.flip(t, axis=2)

    o_b, s_b = chunk_gated_delta(rev(q), rev(k), rev(v), rev(gb), rev(bb), s0[:, 1])
    o = jnp.swapaxes(o_f + rev(o_b), 1, 2)
    z = zc.astype(f32).reshape(Bn, L, N_HEADS_C, HEAD_DIM)
    o = rms_norm(o, norm_g) * jax.nn.silu(z)
    return o.reshape(Bn, L, GROUP_WIDTH).astype(qc.dtype), jnp.stack([s_f, s_b], axis=1)


def fourier_mix(xd):
    Bn, L, _ = xd.shape
    t = xd.astype(jnp.float32).reshape(Bn, L, N_FOURIER_GROUPS, FOURIER_GROUP_DIM)
    y = jnp.fft.fft2(t, axes=(1, 3), norm='ortho').real
    return y.reshape(Bn, L, GROUP_WIDTH).astype(xd.dtype)


def swiglu(h, w1, w3, w2):
    return (jax.nn.silu(h @ w1) * (h @ w3)) @ w2


def token_mix(h, lp, ctx):
    Bn, L, _ = h.shape
    (qa, ka, va, gate_b, gate_c, xb, qc, kc, vc, zc,
     beta_f, beta_b, a_f, a_b, xd) = split_cols(h @ lp['w_in'])
    qa = rms_norm(qa.reshape(Bn, L, N_HEADS_A, HEAD_DIM), lp['q_norm'])
    ka = rms_norm(ka.reshape(Bn, L, KV_HEADS_A, HEAD_DIM), lp['k_norm'])
    va = va.reshape(Bn, L, KV_HEADS_A, HEAD_DIM)
    if ctx is None:
        k_all, v_all = ka, va
        s0 = jnp.zeros((Bn, 2, N_HEADS_C, HEAD_DIM, HEAD_DIM), jnp.float32)
    else:
        k_ctx, v_ctx, s0 = ctx
        qa = rope_2d(qa)
        k_all = jnp.concatenate([jnp.swapaxes(k_ctx, 1, 2).astype(ka.dtype), rope_2d(ka)], axis=1)
        v_all = jnp.concatenate([jnp.swapaxes(v_ctx, 1, 2).astype(va.dtype), va], axis=1)
    o_a = block_attention(qa.reshape(Bn, L, KV_HEADS_A, Q_PER_KV, HEAD_DIM), k_all, v_all)
    o_b = gate_b * depthwise_conv(gate_c * xb, lp['conv_b_w'])
    o_c, s_end = gated_deltanet(qc, kc, vc, zc, beta_f, beta_b, a_f, a_b, lp['conv_c_w'],
                                lp['delta_a_log'], lp['delta_dt_bias'], lp['delta_norm'], s0)
    o_d = fourier_mix(xd)
    out = jnp.concatenate([o_a, o_b, o_c, o_d], axis=-1) @ lp['w_out']
    return out, jnp.swapaxes(ka, 1, 2), jnp.swapaxes(va, 1, 2), s_end.astype(h.dtype)


def trunk_layer(x, cond, lp, ctx):
    mod = (jax.nn.silu(cond) @ lp['mod_w'] + lp['mod_b'])[:, None, :]
    sh1, sc1, g1, shm, scm, gm, sh2, sc2, g2 = jnp.split(mod, N_MOD, axis=-1)
    h = rms_norm(x, lp['norm_ffn1']) * (1.0 + sc1) + sh1
    x = x + 0.5 * g1 * swiglu(h, lp['ffn1_w1'], lp['ffn1_w3'], lp['ffn1_w2'])
    h = rms_norm(x, lp['norm_mix']) * (1.0 + scm) + shm
    out, k_new, v_new, s_new = token_mix(h, lp, ctx)
    x = x + gm * out
    h = rms_norm(x, lp['norm_ffn2']) * (1.0 + sc2) + sh2
    x = x + 0.5 * g2 * swiglu(h, lp['ffn2_w1'], lp['ffn2_w3'], lp['ffn2_w2'])
    return x, k_new, v_new, s_new


def setup_inputs(seed: int = 0) -> dict:
    key = jax.random.key(seed)
    ks = jax.random.split(key, 32)
    f32 = jnp.float32

    def nrm(k, shape, scale):
        return jax.random.normal(k, shape, f32) * scale

    def gain(k, shape):
        return 1.0 + 0.02 * jax.random.normal(k, shape, f32)

    dt = jnp.exp(jax.random.uniform(ks[25], (DEPTH, 2, N_HEADS_C), f32,
                                    math.log(1e-3), math.log(0.1)))
    return {
        'x_prompt': nrm(ks[0], (BATCH, SEQ, D_MODEL), 1.0),
        'x_sample': nrm(ks[1], (DEC_BATCH, DEC_SEQ, D_MODEL), 1.0),
        'c': nrm(ks[2], (DEC_BATCH, D_MODEL), 1.0),
        'cache_k': nrm(ks[3], (DEC_BATCH, DEPTH, KV_HEADS_A, PAST_LEN, HEAD_DIM), 1.0),
        'cache_v': nrm(ks[4], (DEC_BATCH, DEPTH, KV_HEADS_A, PAST_LEN, HEAD_DIM), 1.0),
        'state_delta': nrm(ks[5], (DEC_BATCH, DEPTH, 2, N_HEADS_C, HEAD_DIM, HEAD_DIM), 0.1),
        'c_ctx': nrm(ks[6], (D_MODEL,), 1.0),
        'mod_w': nrm(ks[7], (DEPTH, D_MODEL, N_MOD * D_MODEL), D_MODEL ** -0.5),
        'mod_b': nrm(ks[8], (DEPTH, N_MOD * D_MODEL), 0.02),
        'norm_ffn1': gain(ks[9], (DEPTH, D_MODEL)),
        'norm_mix': gain(ks[10], (DEPTH, D_MODEL)),
        'norm_ffn2': gain(ks[11], (DEPTH, D_MODEL)),
        'ffn1_w1': nrm(ks[12], (DEPTH, D_MODEL, D_FF), D_MODEL ** -0.5),
        'ffn1_w3': nrm(ks[13], (DEPTH, D_MODEL, D_FF), D_MODEL ** -0.5),
        'ffn1_w2': nrm(ks[14], (DEPTH, D_FF, D_MODEL), D_FF ** -0.5),
        'ffn2_w1': nrm(ks[15], (DEPTH, D_MODEL, D_FF), D_MODEL ** -0.5),
        'ffn2_w3': nrm(ks[16], (DEPTH, D_MODEL, D_FF), D_MODEL ** -0.5),
        'ffn2_w2': nrm(ks[17], (DEPTH, D_FF, D_MODEL), D_FF ** -0.5),
        'w_in': nrm(ks[18], (DEPTH, D_MODEL, PROJ_WIDTH), D_MODEL ** -0.5),
        'w_out': nrm(ks[19], (DEPTH, MIX_WIDTH, D_MODEL), MIX_WIDTH ** -0.5),
        'q_norm': gain(ks[20], (DEPTH, HEAD_DIM)),
        'k_norm': gain(ks[21], (DEPTH, HEAD_DIM)),
        'conv_b_w': nrm(ks[22], (DEPTH, SHORT_CONV, GROUP_WIDTH), SHORT_CONV ** -0.5),
        'conv_c_w': nrm(ks[23], (DEPTH, SHORT_CONV, 3 * GROUP_WIDTH), SHORT_CONV ** -0.5),
        'delta_a_log': jnp.log(jax.random.uniform(ks[24], (DEPTH, 2, N_HEADS_C), f32, 1.0, 16.0)),
        'delta_dt_bias': dt + jnp.log(-jnp.expm1(-dt)),
        'delta_norm': gain(ks[26], (DEPTH, HEAD_DIM)),
        'final_norm': gain(ks[27], (D_MODEL,)),
    }


def reference(x_prompt, x_sample, c, cache_k, cache_v, state_delta, c_ctx,
              mod_w, mod_b, norm_ffn1, norm_mix, norm_ffn2,
              ffn1_w1, ffn1_w3, ffn1_w2, ffn2_w1, ffn2_w3, ffn2_w2,
              w_in, w_out, q_norm, k_norm, conv_b_w, conv_c_w,
              delta_a_log, delta_dt_bias, delta_norm, final_norm):
    yp = x_prompt
    ys = x_sample
    cond_ctx = c_ctx[None, :]
    k_list, v_list, s_list = [], [], []
    for l in range(DEPTH):
        lp = {
            'mod_w': mod_w[l], 'mod_b': mod_b[l],
            'norm_ffn1': norm_ffn1[l], 'norm_mix': norm_mix[l], 'norm_ffn2': norm_ffn2[l],
            'ffn1_w1': ffn1_w1[l], 'ffn1_w3': ffn1_w3[l], 'ffn1_w2': ffn1_w2[l],
            'ffn2_w1': ffn2_w1[l], 'ffn2_w3': ffn2_w3[l], 'ffn2_w2': ffn2_w2[l],
            'w_in': w_in[l], 'w_out': w_out[l], 'q_norm': q_norm[l], 'k_norm': k_norm[l],
            'conv_b_w': conv_b_w[l], 'conv_c_w': conv_c_w[l],
            'delta_a_log': delta_a_log[l], 'delta_dt_bias': delta_dt_bias[l],
            'delta_norm': delta_norm[l],
        }
        yp, k_l, v_l, s_l = trunk_layer(yp, cond_ctx, lp, None)
        k_list.append(k_l)
        v_list.append(v_l)
        s_list.append(s_l)
        ys, _, _, _ = trunk_layer(ys, c, lp, (cache_k[:, l], cache_v[:, l], state_delta[:, l]))
    y_prompt = rms_norm(yp, final_norm)
    y_sample = rms_norm(ys, final_norm)
    new_cache_k = jnp.stack(k_list, axis=1)
    new_cache_v = jnp.stack(v_list, axis=1)
    new_state_delta = jnp.stack(s_list, axis=1)
    return (y_prompt, y_sample, new_cache_k, new_cache_v, new_state_delta)
```

```cpp
#include <hip/hip_runtime.h>
#include <hip/hip_cooperative_groups.h>
#include <stdint.h>
#include <stdio.h>
namespace cg = cooperative_groups;

#ifndef MULTI_LAUNCH
#define MULTI_LAUNCH 0
#endif

typedef unsigned short u16;
using bf16x8 = __attribute__((ext_vector_type(8))) short;
using s16x4 = __attribute__((ext_vector_type(4))) short;
using f32x4 = __attribute__((ext_vector_type(4))) float;
#define DI __device__ __forceinline__
#define MFMA16(a, b, c) __builtin_amdgcn_mfma_f32_16x16x32_bf16((a), (b), (c), 0, 0, 0)

constexpr int LDS_BYTES = 73728;
constexpr int TR = 20480;
constexpr int PW = 2304;

constexpr size_t SZ_UPT = 5632ull * 1024 * 2;
constexpr size_t SZ_DNT = 1024ull * 2816 * 2;
constexpr size_t SZ_INT = 2944ull * 1024 * 2;
constexpr size_t SZ_OUTT = 1024ull * 1024 * 2;
constexpr size_t OFF_UPT = 0;
constexpr size_t OFF_DNT = OFF_UPT + 4 * SZ_UPT;
constexpr size_t OFF_INT = OFF_DNT + 4 * SZ_DNT;
constexpr size_t OFF_OUTT = OFF_INT + 2 * SZ_INT;
constexpr size_t OFF_MOD = OFF_OUTT + 2 * SZ_OUTT;
constexpr size_t OFF_ROPE = OFF_MOD + 663552;
constexpr size_t OFF_DFTL = OFF_ROPE + 8192;
constexpr size_t OFF_DFTC = OFF_DFTL + 67108864;
constexpr size_t OFF_H = OFF_DFTC + 262144;
constexpr size_t OFF_X = OFF_H + 83886080;
constexpr size_t OFF_ACT = OFF_X;
constexpr size_t OFF_P = OFF_X;
constexpr size_t OFF_GATES = OFF_P + 94371840;
constexpr size_t OFF_XTC = OFF_GATES + 1310720;
constexpr size_t OFF_XTL = OFF_XTC + 4194304;
constexpr size_t OFF_QB = OFF_XTL + 16777216;
constexpr size_t OFF_KBC = OFF_QB + 10485760;
constexpr size_t OFF_KBL = OFF_KBC + 1048576;
constexpr size_t OFF_VTC = OFF_KBL + 4718592;
constexpr size_t OFF_VTL = OFF_VTC + 1048576;
constexpr size_t OFF_DN = OFF_VTL + 4718592;
constexpr size_t OFF_GL = OFF_DN + 104857600;
constexpr size_t OFF_ODIR = OFF_GL + 10240;
constexpr size_t WS_END = OFF_ODIR + 20971520;

constexpr size_t OUT_K = 41943040;
constexpr size_t OUT_V = 44040192;
constexpr size_t OUT_S = 46137344;

struct Params {
  const float *x_prompt, *x_sample, *c, *cache_k, *cache_v, *state_delta, *c_ctx, *mod_w, *mod_b, *norm_ffn1, *norm_mix,
      *norm_ffn2, *ffn1_w1, *ffn1_w3, *ffn1_w2, *ffn2_w1, *ffn2_w3, *ffn2_w2, *w_in, *w_out, *q_norm, *k_norm, *conv_b_w,
      *conv_c_w, *delta_a_log, *delta_dt_bias, *delta_norm, *final_norm;
  float* out;
  char* ws;
};

DI int opaque_tid() { int t = threadIdx.x; asm volatile("" : "+v"(t)); return t; }
DI short f2bf(float x) {
  unsigned u = __float_as_uint(x);
  u += 0x7fffu + ((u >> 16) & 1u);
  return (short)(u >> 16);
}
DI float bf2f(u16 b) { return __uint_as_float(((unsigned)b) << 16); }
DI unsigned pack2bf(float a, float b) { return ((unsigned)(u16)f2bf(a)) | (((unsigned)(u16)f2bf(b)) << 16); }
DI float siluf(float x) { return x / (1.f + __expf(-x)); }
DI bf16x8 pack8(f32x4 lo, f32x4 hi) {
  bf16x8 r;
  r[0] = f2bf(lo[0]); r[1] = f2bf(lo[1]); r[2] = f2bf(lo[2]); r[3] = f2bf(lo[3]);
  r[4] = f2bf(hi[0]); r[5] = f2bf(hi[1]); r[6] = f2bf(hi[2]); r[7] = f2bf(hi[3]);
  return r;
}
DI bf16x8 frag_perm(const u16* base, int row, int ks, int g) {
  const u16* q = base + row * 72 + ks * 32 + g * 4;
  s16x4 lo = *(const s16x4*)q;
  s16x4 hi = *(const s16x4*)(q + 16);
  return __builtin_shufflevector(lo, hi, 0, 1, 2, 3, 4, 5, 6, 7);
}
DI void unpack8(uint4 v, float* f) {
  f[0] = __uint_as_float(v.x << 16); f[1] = __uint_as_float(v.x & 0xffff0000u);
  f[2] = __uint_as_float(v.y << 16); f[3] = __uint_as_float(v.y & 0xffff0000u);
  f[4] = __uint_as_float(v.z << 16); f[5] = __uint_as_float(v.z & 0xffff0000u);
  f[6] = __uint_as_float(v.w << 16); f[7] = __uint_as_float(v.w & 0xffff0000u);
}
DI int grow_of(int u, int r) { return u < 4096 ? u + 4096 * r : u + 4096 + 16384 * r; }
DI int modv_of(int grow) { return grow < 8192 ? 0 : 1 + ((grow - 8192) >> 12); }

template <class Epi>
DI void gemm_tile(char* smem, const u16* __restrict__ A, int lda, const u16* __restrict__ Bt, int ldb, int K, Epi epi) {
  u16* sa = (u16*)smem;
  u16* sb = (u16*)(smem + 36864);
  const int tid = opaque_tid(), lane = tid & 63, w = tid >> 6, wm = w >> 1, wn = w & 1;
  const int l15 = lane & 15, g = lane >> 4;
  f32x4 acc[4][4];
#pragma unroll
  for (int i = 0; i < 4; ++i)
#pragma unroll
    for (int j = 0; j < 4; ++j) acc[i][j] = f32x4{0.f, 0.f, 0.f, 0.f};
  const int lrow = tid >> 3, lkc = (tid & 7) * 8;
  uint4 ra[4], rb[4];
  const int KT = K >> 6;
#pragma unroll
  for (int i = 0; i < 4; ++i) {
    ra[i] = *(const uint4*)(A + (size_t)(lrow + i * 32) * lda + lkc);
    rb[i] = *(const uint4*)(Bt + (size_t)(lrow + i * 32) * ldb + lkc);
  }
#pragma unroll
  for (int i = 0; i < 4; ++i) {
    *(uint4*)(sa + (lrow + i * 32) * 72 + lkc) = ra[i];
    *(uint4*)(sb + (lrow + i * 32) * 72 + lkc) = rb[i];
  }
  __syncthreads();
  for (int kt = 0; kt < KT; ++kt) {
    const int buf = kt & 1;
    if (kt + 1 < KT) {
#pragma unroll
      for (int i = 0; i < 4; ++i) {
        ra[i] = *(const uint4*)(A + (size_t)(lrow + i * 32) * lda + (kt + 1) * 64 + lkc);
        rb[i] = *(const uint4*)(Bt + (size_t)(lrow + i * 32) * ldb + (kt + 1) * 64 + lkc);
      }
    }
    const u16* ca = sa + buf * 9216;
    const u16* cb = sb + buf * 9216;
#pragma unroll
    for (int ks = 0; ks < 2; ++ks) {
      bf16x8 fn[4], fm[4];
#pragma unroll
      for (int j = 0; j < 4; ++j) fn[j] = *(const bf16x8*)(cb + (wn * 64 + j * 16 + l15) * 72 + ks * 32 + g * 8);
#pragma unroll
      for (int i = 0; i < 4; ++i) fm[i] = *(const bf16x8*)(ca + (wm * 64 + i * 16 + l15) * 72 + ks * 32 + g * 8);
#pragma unroll
      for (int i = 0; i < 4; ++i)
#pragma unroll
        for (int j = 0; j < 4; ++j) acc[i][j] = MFMA16(fn[j], fm[i], acc[i][j]);
    }
    if (kt + 1 < KT) {
      u16* da = sa + (buf ^ 1) * 9216;
      u16* db = sb + (buf ^ 1) * 9216;
#pragma unroll
      for (int i = 0; i < 4; ++i) {
        *(uint4*)(da + (lrow + i * 32) * 72 + lkc) = ra[i];
        *(uint4*)(db + (lrow + i * 32) * 72 + lkc) = rb[i];
      }
    }
    __syncthreads();
  }
#pragma unroll
  for (int i = 0; i < 4; ++i)
#pragma unroll
    for (int j = 0; j < 4; ++j) epi(wm * 64 + i * 16 + l15, wn * 64 + j * 16 + g * 4, i, j, acc);
}

DI int rowmap(int mode, int n) {
  if (mode == 0) return n;
  if (mode == 1) return (n >> 4) * 32 + (n & 15);
  if (mode == 2) return (n >> 4) * 32 + 16 + (n & 15);
  return 2816 + (n - 2304);
}
DI void transpose_item(char* smem, const float* __restrict__ W, int ldw, int k0, int n0, int nvalid, u16* dst, int ldd, int mode) {
  float* tile = (float*)smem;
  const int tid = opaque_tid(), tx = tid & 63, ty = tid >> 6;
  for (int r = ty; r < 64; r += 4) tile[r * 65 + tx] = (tx < nvalid) ? W[(size_t)(k0 + r) * ldw + n0 + tx] : 0.f;
  __syncthreads();
  const int n = tid >> 2, kq = tid & 3;
  if (n < nvalid) {
    unsigned pk[8];
#pragma unroll
    for (int j = 0; j < 8; ++j) pk[j] = pack2bf(tile[(kq * 16 + 2 * j) * 65 + n], tile[(kq * 16 + 2 * j + 1) * 65 + n]);
    u16* d = dst + (size_t)rowmap(mode, n0 + n) * ldd + k0 + kq * 16;
    *(uint4*)d = uint4{pk[0], pk[1], pk[2], pk[3]};
    *(uint4*)(d + 8) = uint4{pk[4], pk[5], pk[6], pk[7]};
  }
  __syncthreads();
}

DI void fold_item(char* smem, const Params& p, int l, int it) {
  float* tile = (float*)smem;
  float* trig = tile + 64 * 65;
  const int tid = opaque_tid(), tx = tid & 63, ty = tid >> 6;
  const int wg = it >> 4, which = wg >> 2, g = wg & 3, k0 = (it & 15) * 64;
  const float* W = p.w_in + (size_t)l * 1024 * 2576;
  for (int r = ty; r < 64; r += 4) tile[r * 65 + tx] = W[(size_t)(k0 + r) * 2576 + 2320 + g * 64 + tx];
  if (tid < 64) {
    float s, c;
    sincospif((float)tid / 32.f, &s, &c);
    trig[tid] = which ? s : c;
  }
  __syncthreads();
  const int kc = tid & 63, kq = tid >> 6;
  float acc[16];
#pragma unroll
  for (int j = 0; j < 16; ++j) acc[j] = 0.f;
  for (int cidx = 0; cidx < 64; ++cidx) {
    const float t = trig[(cidx * kc) & 63];
#pragma unroll
    for (int j = 0; j < 16; ++j) acc[j] += tile[(kq * 16 + j) * 65 + cidx] * t;
  }
  u16* dst = (u16*)(p.ws + OFF_INT + (size_t)l * SZ_INT) + (size_t)(2304 + which * 256 + g * 64 + kc) * 1024 + k0 + kq * 16;
  unsigned pk[8];
#pragma unroll
  for (int j = 0; j < 8; ++j) pk[j] = pack2bf(acc[2 * j], acc[2 * j + 1]);
  *(uint4*)dst = uint4{pk[0], pk[1], pk[2], pk[3]};
  *(uint4*)(dst + 8) = uint4{pk[4], pk[5], pk[6], pk[7]};
  __syncthreads();
}

DI void dft_row_item(const Params& p, int it) {
  const bool lat = it < 4096;
  const int L = lat ? 4096 : 256;
  const int kL = lat ? it : it - 4096;
  u16* row = (u16*)(p.ws + (lat ? OFF_DFTL : OFF_DFTC)) + (size_t)kL * 2 * L;
  const float inv = 2.f / (float)L;
  for (int cch = threadIdx.x; cch < L / 8; cch += 256) {
    unsigned pc[4], ps[4];
#pragma unroll
    for (int j = 0; j < 4; ++j) {
      float s0, c0, s1, c1;
      const int l0 = cch * 8 + 2 * j;
      sincospif((float)((kL * l0) & (L - 1)) * inv, &s0, &c0);
      sincospif((float)((kL * (l0 + 1)) & (L - 1)) * inv, &s1, &c1);
      pc[j] = pack2bf(c0, c1);
      ps[j] = pack2bf(-s0, -s1);
    }
    *(uint4*)(row + cch * 8) = uint4{pc[0], pc[1], pc[2], pc[3]};
    *(uint4*)(row + L + cch * 8) = uint4{ps[0], ps[1], ps[2], ps[3]};
  }
}

DI void rope_item(const Params& p, int it) {
  const int e = it * 256 + threadIdx.x;
  const int pos = e >> 4, i = e & 15;
  const float inv_freq = powf(10000.f, -(float)i / 16.f);
  const float ang = (float)pos * inv_freq;
  float* rope = (float*)(p.ws + OFF_ROPE);
  rope[e * 2] = cosf(ang);
  rope[e * 2 + 1] = sinf(ang);
}

DI void mod_item(char* smem, const Params& p, int it) {
  const int l = it / 144, cb = it % 144, n0 = cb * 64;
  float* sc = (float*)smem;
  float* red = (float*)(smem + 36864);
  const int tid = opaque_tid();
  for (int e = tid; e < 9216; e += 256) {
    const int v = e >> 10, k = e & 1023;
    const float val = v == 0 ? p.c_ctx[k] : p.c[(v - 1) * 1024 + k];
    sc[e] = siluf(val);
  }
  __syncthreads();
  const int kg = tid >> 4, c4 = tid & 15;
  float acc[9][4];
#pragma unroll
  for (int v = 0; v < 9; ++v)
#pragma unroll
    for (int j = 0; j < 4; ++j) acc[v][j] = 0.f;
  const float* W = p.mod_w + (size_t)l * 1024 * 9216 + n0 + c4 * 4;
#pragma unroll 4
  for (int kk = 0; kk < 64; ++kk) {
    const int k = kg * 64 + kk;
    const float4 wv = *(const float4*)(W + (size_t)k * 9216);
#pragma unroll
    for (int v = 0; v < 9; ++v) {
      const float s = sc[v * 1024 + k];
      acc[v][0] += s * wv.x; acc[v][1] += s * wv.y; acc[v][2] += s * wv.z; acc[v][3] += s * wv.w;
    }
  }
#pragma unroll
  for (int v = 0; v < 9; ++v)
#pragma unroll
    for (int j = 0; j < 4; ++j) red[(kg * 9 + v) * 64 + c4 * 4 + j] = acc[v][j];
  __syncthreads();
  float* MOD = (float*)(p.ws + OFF_MOD);
  for (int e = tid; e < 576; e += 256) {
    const int v = e >> 6, cc = e & 63;
    float s = p.mod_b[l * 9216 + n0 + cc];
#pragma unroll
    for (int q = 0; q < 16; ++q) s += red[(q * 9 + v) * 64 + cc];
    MOD[(size_t)(l * 9 + v) * 9216 + n0 + cc] = s;
  }
  __syncthreads();
}

DI void phase_init(char* smem, const Params& p, int bid, int nb) {
  constexpr int N_T = 10144, N_F = 256, N_D = 4352, N_R = 4, N_M = 288;
  for (int it = bid; it < N_T + N_F + N_D + N_R + N_M; it += nb) {
    if (it < N_T) {
      const int l = it / 5072, j = it % 5072;
      if (j < 4224) {
        const int f = j / 2112, jj = j % 2112, m = jj / 704, q = jj % 704;
        const float* w1 = (f ? p.ffn2_w1 : p.ffn1_w1) + (size_t)l * 1024 * 2816;
        const float* w3 = (f ? p.ffn2_w3 : p.ffn1_w3) + (size_t)l * 1024 * 2816;
        const float* w2 = (f ? p.ffn2_w2 : p.ffn1_w2) + (size_t)l * 2816 * 1024;
        if (m < 2) {
          u16* dst = (u16*)(p.ws + OFF_UPT + (size_t)(l * 2 + f) * SZ_UPT);
          transpose_item(smem, m ? w3 : w1, 2816, (q / 44) * 64, (q % 44) * 64, 64, dst, 1024, m ? 2 : 1);
        } else {
          u16* dst = (u16*)(p.ws + OFF_DNT + (size_t)(l * 2 + f) * SZ_DNT);
          transpose_item(smem, w2, 1024, (q / 16) * 64, (q % 16) * 64, 64, dst, 2816, 0);
        }
      } else if (j < 4816) {
        const int q = j - 4224, kt = q / 37, nt = q % 37;
        u16* dst = (u16*)(p.ws + OFF_INT + (size_t)l * SZ_INT);
        transpose_item(smem, p.w_in + (size_t)l * 1024 * 2576, 2576, kt * 64, nt * 64, nt < 36 ? 64 : 16, dst, 1024, nt < 36 ? 0 : 3);
      } else {
        const int q = j - 4816;
        u16* dst = (u16*)(p.ws + OFF_OUTT + (size_t)l * SZ_OUTT);
        transpose_item(smem, p.w_out + (size_t)l * 1024 * 1024, 1024, (q / 16) * 64, (q % 16) * 64, 64, dst, 1024, 0);
      }
    } else if (it < N_T + N_F) {
      const int j = it - N_T;
      fold_item(smem, p, j >> 7, j & 127);
    } else if (it < N_T + N_F + N_D) {
      dft_row_item(p, it - N_T - N_F);
    } else if (it < N_T + N_F + N_D + N_R) {
      rope_item(p, it - N_T - N_F - N_D);
    } else {
      mod_item(smem, p, it - N_T - N_F - N_D - N_R);
    }
  }
}

DI const float* xsrc_row(const Params& p, bool from_in, int grow) {
  if (from_in) return grow < 8192 ? p.x_prompt + (size_t)grow * 1024 : p.x_sample + (size_t)(grow - 8192) * 1024;
  return p.out + (size_t)grow * 1024;
}
DI float wave_sum(float v) {
#pragma unroll
  for (int o = 32; o > 0; o >>= 1) v += __shfl_xor(v, o);
  return v;
}
DI void phase_norm(const Params& p, int l, int which, int bid, int nb) {
  const int lane = threadIdx.x & 63, w = threadIdx.x >> 6;
  const float* gain = (which == 0 ? p.norm_ffn1 : which == 1 ? p.norm_mix : p.norm_ffn2) + l * 1024;
  const float* MOD = (const float*)(p.ws + OFF_MOD);
  u16* H = (u16*)(p.ws + OFF_H);
  const bool from_in = (l == 0 && which == 0);
  for (int row = bid * 4 + w; row < 40960; row += nb * 4) {
    const float* x = xsrc_row(p, from_in, row);
    const float* mv = MOD + (size_t)(l * 9 + modv_of(row)) * 9216 + which * 3 * 1024;
    float4 xv[4];
    float ss = 0.f;
#pragma unroll
    for (int i = 0; i < 4; ++i) {
      xv[i] = *(const float4*)(x + i * 256 + lane * 4);
      ss += xv[i].x * xv[i].x + xv[i].y * xv[i].y + xv[i].z * xv[i].z + xv[i].w * xv[i].w;
    }
    ss = wave_sum(ss);
    const float rstd = rsqrtf(ss * (1.f / 1024.f) + 1e-6f);
#pragma unroll
    for (int i = 0; i < 4; ++i) {
      const int k = i * 256 + lane * 4;
      const float4 gv = *(const float4*)(gain + k);
      const float4 sh = *(const float4*)(mv + k);
      const float4 scv = *(const float4*)(mv + 1024 + k);
      const float h0 = xv[i].x * rstd * gv.x * (1.f + scv.x) + sh.x;
      const float h1 = xv[i].y * rstd * gv.y * (1.f + scv.y) + sh.y;
      const float h2 = xv[i].z * rstd * gv.z * (1.f + scv.z) + sh.z;
      const float h3 = xv[i].w * rstd * gv.w * (1.f + scv.w) + sh.w;
      *(uint2*)(H + (size_t)row * 1024 + k) = uint2{pack2bf(h0, h1), pack2bf(h2, h3)};
    }
  }
}
DI void phase_final(const Params& p, int bid, int nb) {
  const int lane = threadIdx.x & 63, w = threadIdx.x >> 6;
  for (int row = bid * 4 + w; row < 40960; row += nb * 4) {
    float* x = p.out + (size_t)row * 1024;
    float4 xv[4];
    float ss = 0.f;
#pragma unroll
    for (int i = 0; i < 4; ++i) {
      xv[i] = *(const float4*)(x + i * 256 + lane * 4);
      ss += xv[i].x * xv[i].x + xv[i].y * xv[i].y + xv[i].z * xv[i].z + xv[i].w * xv[i].w;
    }
    ss = wave_sum(ss);
    const float rstd = rsqrtf(ss * (1.f / 1024.f) + 1e-6f);
#pragma unroll
    for (int i = 0; i < 4; ++i) {
      const int k = i * 256 + lane * 4;
      const float4 gv = *(const float4*)(p.final_norm + k);
      *(float4*)(x + k) = float4{xv[i].x * rstd * gv.x, xv[i].y * rstd * gv.y, xv[i].z * rstd * gv.z, xv[i].w * rstd * gv.w};
    }
  }
}

DI void phase_up(char* smem, const Params& p, int l, int f, int bid, int nb) {
  const u16* H = (const u16*)(p.ws + OFF_H);
  const u16* Wt = (const u16*)(p.ws + OFF_UPT + (size_t)(l * 2 + f) * SZ_UPT);
  u16* ACT = (u16*)(p.ws + OFF_ACT);
  for (int t = bid; t < 320 * 44; t += nb) {
    const int mt = t / 44, nt = t % 44;
    auto epi = [&](int ml, int nl, int i, int j, f32x4 (*acc)[4]) {
      if (j & 1) return;
      const f32x4 a = acc[i][j], b = acc[i][j + 1];
      const int col = (nt * 4 + (nl >> 5)) * 16 + (nl & 15);
      const size_t row = (size_t)mt * 128 + ml;
      *(uint2*)(ACT + row * 2816 + col) = uint2{pack2bf(siluf(a[0]) * b[0], siluf(a[1]) * b[1]), pack2bf(siluf(a[2]) * b[2], siluf(a[3]) * b[3])};
    };
    gemm_tile(smem, H + (size_t)mt * 128 * 1024, 1024, Wt + (size_t)nt * 128 * 1024, 1024, 1024, epi);
  }
}
DI void phase_resid(char* smem, const Params& p, const u16* A, int lda, const u16* Wt, int K, int l, int gate_chunk, float coef, bool from_in, int bid, int nb) {
  const float* MOD = (const float*)(p.ws + OFF_MOD);
  for (int t = bid; t < 320 * 8; t += nb) {
    const int mt = t >> 3, nt = t & 7;
    auto epi = [&](int ml, int nl, int i, int j, f32x4 (*acc)[4]) {
      const int row = mt * 128 + ml, n = nt * 128 + nl;
      const float4 gv = *(const float4*)(MOD + (size_t)(l * 9 + modv_of(row)) * 9216 + gate_chunk * 1024 + n);
      const float4 xv = *(const float4*)(xsrc_row(p, from_in, row) + n);
      const f32x4 a = acc[i][j];
      *(float4*)(p.out + (size_t)row * 1024 + n) = float4{xv.x + coef * gv.x * a[0], xv.y + coef * gv.y * a[1], xv.z + coef * gv.z * a[2], xv.w + coef * gv.w * a[3]};
    };
    gemm_tile(smem, A + (size_t)mt * 128 * lda, lda, Wt + (size_t)nt * 128 * K, K, K, epi);
  }
}
DI void phase_proj(char* smem, const Params& p, int l, int r, int bid, int nb) {
  const u16* H = (const u16*)(p.ws + OFF_H);
  const u16* Wt = (const u16*)(p.ws + OFF_INT + (size_t)l * SZ_INT);
  u16* P = (u16*)(p.ws + OFF_P);
  float* GATES = (float*)(p.ws + OFF_GATES);
  u16* XTC = (u16*)(p.ws + OFF_XTC);
  u16* XTL = (u16*)(p.ws + OFF_XTL);
  for (int t = bid; t < 160 * 23; t += nb) {
    const int mt = t / 23, nt = t % 23;
    const int u0 = mt * 128;
    auto epi = [&](int ml, int nl, int i, int j, f32x4 (*acc)[4]) {
      const int u = u0 + ml, n = nt * 128 + nl;
      const f32x4 a = acc[i][j];
      if (nt < 18) {
        *(uint2*)(P + (size_t)u * PW + n) = uint2{pack2bf(a[0], a[1]), pack2bf(a[2], a[3])};
      } else if (nt < 22) {
        const int n2 = n - 2304, which = n2 >> 8, nn = n2 & 255;
        if (u < 4096) {
          const int bl = u >> 8, lp = u & 255;
          u16* d = XTC + ((size_t)(bl * 256 + nn) * 512) + which * 256 + lp;
#pragma unroll
          for (int q = 0; q < 4; ++q) d[(size_t)q * 512] = (u16)f2bf(a[q]);
        } else {
          const int ul = u - 4096, bl = ul >> 12, lp = ul & 4095;
          u16* d = XTL + ((size_t)(bl * 256 + nn) * 8192) + which * 4096 + lp;
#pragma unroll
          for (int q = 0; q < 4; ++q) d[(size_t)q * 8192] = (u16)f2bf(a[q]);
        }
      } else {
        if (nl < 16) *(float4*)(GATES + (size_t)u * 16 + nl) = float4{a[0], a[1], a[2], a[3]};
      }
    };
    gemm_tile(smem, H + (size_t)grow_of(u0, r) * 1024, 1024, Wt + (size_t)nt * 128 * 1024, 1024, 1024, epi);
  }
}

DI void load64(const u16* src, float* v) {
#pragma unroll
  for (int i = 0; i < 8; ++i) unpack8(*(const uint4*)(src + i * 8), v + i * 8);
}
DI void store64(u16* dst, const float* v) {
#pragma unroll
  for (int i = 0; i < 8; ++i)
    *(uint4*)(dst + i * 8) = uint4{pack2bf(v[i * 8], v[i * 8 + 1]), pack2bf(v[i * 8 + 2], v[i * 8 + 3]), pack2bf(v[i * 8 + 4], v[i * 8 + 5]), pack2bf(v[i * 8 + 6], v[i * 8 + 7])};
}
DI void rope64(const float* rope, int pos, float* v) {
  const float* rr = rope + (pos >> 6) * 32;
  const float* rc = rope + (pos & 63) * 32;
#pragma unroll
  for (int i = 0; i < 16; ++i) {
    const float c = rr[i * 2], s = rr[i * 2 + 1];
    const float a = v[i], b = v[16 + i];
    v[i] = a * c - b * s;
    v[16 + i] = b * c + a * s;
    const float c2 = rc[i * 2], s2 = rc[i * 2 + 1];
    const float a2 = v[32 + i], b2 = v[48 + i];
    v[32 + i] = a2 * c2 - b2 * s2;
    v[48 + i] = b2 * c2 + a2 * s2;
  }
}
DI void prep_attn_item(const Params& p, int l, int r, int item) {
  const int tid = opaque_tid(), tk = tid & 63, hh = tid >> 6;
  const int u = item * 64 + tk;
  const bool lat = u >= 4096;
  const u16* prow = (const u16*)(p.ws + OFF_P) + (size_t)u * PW;
  const float* rope = (const float*)(p.ws + OFF_ROPE);
  int bl, pos;
  if (!lat) { bl = u >> 8; pos = u & 255; } else { bl = (u - 4096) >> 12; pos = (u - 4096) & 4095; }
  float v[64];
  {
    load64(prow + hh * 64, v);
    float ss = 0.f;
#pragma unroll
    for (int d = 0; d < 64; ++d) ss += v[d] * v[d];
    const float rstd = rsqrtf(ss * (1.f / 64.f) + 1e-6f);
#pragma unroll
    for (int d = 0; d < 64; ++d) v[d] = v[d] * rstd * p.q_norm[l * 64 + d];
    if (lat) rope64(rope, pos, v);
#pragma unroll
    for (int d = 0; d < 64; ++d) v[d] *= 0.125f;
    store64((u16*)(p.ws + OFF_QB) + ((size_t)u * 4 + hh) * 64, v);
  }
  const int kvh = hh & 1;
  if (hh < 2) {
    load64(prow + 256 + kvh * 64, v);
    float ss = 0.f;
#pragma unroll
    for (int d = 0; d < 64; ++d) ss += v[d] * v[d];
    const float rstd = rsqrtf(ss * (1.f / 64.f) + 1e-6f);
#pragma unroll
    for (int d = 0; d < 64; ++d) v[d] = v[d] * rstd * p.k_norm[l * 64 + d];
    if (!lat) {
      const int b = r * 16 + bl;
      float* o = p.out + OUT_K + ((size_t)((b * 2 + l) * 2 + kvh) * 256 + pos) * 64;
#pragma unroll
      for (int d = 0; d < 64; d += 4) *(float4*)(o + d) = float4{v[d], v[d + 1], v[d + 2], v[d + 3]};
      store64((u16*)(p.ws + OFF_KBC) + ((size_t)(bl * 2 + kvh) * 256 + pos) * 64, v);
    } else {
      rope64(rope, pos, v);
      store64((u16*)(p.ws + OFF_KBL) + ((size_t)(bl * 2 + kvh) * 4608 + 512 + pos) * 64, v);
    }
  } else {
    load64(prow + 384 + kvh * 64, v);
    if (!lat) {
      const int b = r * 16 + bl;
      float* o = p.out + OUT_V + ((size_t)((b * 2 + l) * 2 + kvh) * 256 + pos) * 64;
#pragma unroll
      for (int d = 0; d < 64; d += 4) *(float4*)(o + d) = float4{v[d], v[d + 1], v[d + 2], v[d + 3]};
      u16* vt = (u16*)(p.ws + OFF_VTC) + (size_t)(bl * 2 + kvh) * 64 * 256 + pos;
#pragma unroll
      for (int d = 0; d < 64; ++d) vt[(size_t)d * 256] = (u16)f2bf(v[d]);
    } else {
      u16* vt = (u16*)(p.ws + OFF_VTL) + (size_t)(bl * 2 + kvh) * 64 * 4608 + 512 + pos;
#pragma unroll
      for (int d = 0; d < 64; ++d) vt[(size_t)d * 4608] = (u16)f2bf(v[d]);
    }
  }
}
DI void prep_cache_item(const Params& p, int l, int r, int item) {
  const int bl = item >> 4, kvh = (item >> 3) & 1, pblk = item & 7;
  const int tid = opaque_tid(), pp = tid & 63, dq = tid >> 6;
  const int b = r * 4 + bl, pos = pblk * 64 + pp;
  const size_t src = ((size_t)((b * 2 + l) * 2 + kvh) * 512 + pos) * 64 + dq * 16;
  u16* kb = (u16*)(p.ws + OFF_KBL) + ((size_t)(bl * 2 + kvh) * 4608 + pos) * 64 + dq * 16;
  u16* vt = (u16*)(p.ws + OFF_VTL) + ((size_t)(bl * 2 + kvh) * 64 + dq * 16) * 4608 + pos;
  float kv[16], vv[16];
#pragma unroll
  for (int j = 0; j < 4; ++j) {
    const float4 a = *(const float4*)(p.cache_k + src + j * 4);
    const float4 c = *(const float4*)(p.cache_v + src + j * 4);
    kv[j * 4] = a.x; kv[j * 4 + 1] = a.y; kv[j * 4 + 2] = a.z; kv[j * 4 + 3] = a.w;
    vv[j * 4] = c.x; vv[j * 4 + 1] = c.y; vv[j * 4 + 2] = c.z; vv[j * 4 + 3] = c.w;
  }
  *(uint4*)kb = uint4{pack2bf(kv[0], kv[1]), pack2bf(kv[2], kv[3]), pack2bf(kv[4], kv[5]), pack2bf(kv[6], kv[7])};
  *(uint4*)(kb + 8) = uint4{pack2bf(kv[8], kv[9]), pack2bf(kv[10], kv[11]), pack2bf(kv[12], kv[13]), pack2bf(kv[14], kv[15])};
#pragma unroll
  for (int j = 0; j < 16; ++j) vt[(size_t)j * 4608] = (u16)f2bf(vv[j]);
}
DI void prep_convb_item(const Params& p, int l, int r, int item) {
  const int idx = item * 256 + threadIdx.x;
  const int u = idx >> 5, c0 = (idx & 31) * 8;
  const u16* P = (const u16*)(p.ws + OFF_P);
  const int pos = u < 4096 ? (u & 255) : ((u - 4096) & 4095);
  const int L = u < 4096 ? 256 : 4096;
  const float* cw = p.conv_b_w + l * 768;
  float gb[8], gc[8], xb[8], y[8];
  unpack8(*(const uint4*)(P + (size_t)u * PW + 512 + c0), gb);
#pragma unroll
  for (int j = 0; j < 8; ++j) y[j] = 0.f;
#pragma unroll
  for (int dt = 0; dt < 3; ++dt) {
    const int pp = pos + dt - 1;
    if (pp >= 0 && pp < L) {
      const size_t ro = (size_t)(u + dt - 1) * PW;
      unpack8(*(const uint4*)(P + ro + 768 + c0), gc);
      unpack8(*(const uint4*)(P + ro + 1024 + c0), xb);
#pragma unroll
      for (int j = 0; j < 8; ++j) y[j] += gc[j] * xb[j] * cw[dt * 256 + c0 + j];
    }
  }
  u16* M = (u16*)(p.ws + OFF_H) + (size_t)grow_of(u, r) * 1024 + 256 + c0;
  *(uint4*)M = uint4{pack2bf(gb[0] * y[0], gb[1] * y[1]), pack2bf(gb[2] * y[2], gb[3] * y[3]), pack2bf(gb[4] * y[4], gb[5] * y[5]), pack2bf(gb[6] * y[6], gb[7] * y[7])};
}

DI void prep_delta_item(char* smem, const Params& p, int l, int r, int item) {
  const int cpos = item >> 2, h = item & 3;
  const int tid = opaque_tid(), lane = tid & 63, w = tid >> 6, l15 = lane & 15, g = lane >> 4;
  u16* sQ = (u16*)smem;
  u16* sK = sQ + 4608;
  u16* sV = sK + 4608;
  float* sL = (float*)(smem + 27648);
  float* sGc = (float*)(smem + 27648 + 36864);
  float* sBeta = sGc + 128;
  const int u0 = cpos * 64;
  const bool lat = u0 >= 4096;
  const int L = lat ? 4096 : 256;
  const int ul = lat ? u0 - 4096 : u0;
  const int bl = lat ? (ul >> 12) : (ul >> 8);
  const int n = (ul & (L - 1)) >> 6;
  const int NC = L >> 6;
  const u16* P = (const u16*)(p.ws + OFF_P);
  const float* GATES = (const float*)(p.ws + OFF_GATES);
  {
    const int i = tid >> 2, dq = tid & 3;
    const int u = u0 + i;
    const int pos = (ul & (L - 1)) + i;
    const float* cw = p.conv_c_w + l * 3 * 768;
#pragma unroll 1
    for (int which = 0; which < 3; ++which) {
      const int ch = which * 256 + h * 64 + dq * 16;
      float y[16];
#pragma unroll
      for (int j = 0; j < 16; ++j) y[j] = 0.f;
#pragma unroll
      for (int dt = 0; dt < 3; ++dt) {
        const int pp = pos + dt - 1;
        if (pp >= 0 && pp < L) {
          float xin[16];
          const u16* src = P + (size_t)(u + dt - 1) * PW + 1280 + ch;
          unpack8(*(const uint4*)src, xin);
          unpack8(*(const uint4*)(src + 8), xin + 8);
#pragma unroll
          for (int j = 0; j < 16; ++j) y[j] += xin[j] * cw[dt * 768 + ch + j];
        }
      }
      float ss = 0.f;
#pragma unroll
      for (int j = 0; j < 16; ++j) { y[j] = siluf(y[j]); ss += y[j] * y[j]; }
      if (which < 2) {
        ss += __shfl_xor(ss, 1);
        ss += __shfl_xor(ss, 2);
        const float sc = rsqrtf(ss + 1e-6f) * (which == 0 ? 0.125f : 1.f);
#pragma unroll
        for (int j = 0; j < 16; ++j) y[j] *= sc;
      }
      u16* dst = (which == 0 ? sQ : which == 1 ? sK : sV) + i * 72 + dq * 16;
      *(uint4*)dst = uint4{pack2bf(y[0], y[1]), pack2bf(y[2], y[3]), pack2bf(y[4], y[5]), pack2bf(y[6], y[7])};
      *(uint4*)(dst + 8) = uint4{pack2bf(y[8], y[9]), pack2bf(y[10], y[11]), pack2bf(y[12], y[13]), pack2bf(y[14], y[15])};
    }
  }
  if (w < 2) {
    const int dir = w;
    const int i = dir ? 63 - lane : lane;
    const float* gr = GATES + (size_t)(u0 + i) * 16;
    const float braw = gr[dir * 4 + h], araw = gr[8 + dir * 4 + h];
    const float beta = 1.f / (1.f + __expf(-braw));
    const float xx = araw + p.delta_dt_bias[(l * 2 + dir) * 4 + h];
    const float sp = fmaxf(xx, 0.f) + log1pf(__expf(-fabsf(xx)));
    float gv = -__expf(p.delta_a_log[(l * 2 + dir) * 4 + h]) * sp;
#pragma unroll
    for (int o = 1; o < 64; o <<= 1) {
      const float t = __shfl_up(gv, o);
      if (lane >= o) gv += t;
    }
    sGc[dir * 64 + lane] = gv;
    sBeta[dir * 64 + lane] = beta;
  }
  __syncthreads();
  const int dir = w >> 1, half = w & 1;
  const int cid = lat ? 256 + ((bl * 4 + h) * 64 + (dir ? NC - 1 - n : n)) : ((bl * 4 + h) * 4 + (dir ? NC - 1 - n : n));
  u16* dn = (u16*)(p.ws + OFF_DN + (size_t)(dir * 1280 + cid) * 40960);
  u16* dW = dn, *dQG = dn + 4096, *dAQK = dn + 8192, *dKT = dn + 12288, *dU = dn + 16384;
  const float* gc = sGc + dir * 64;
  {
    float* Ld = sL + dir * 4608;
#pragma unroll
    for (int ii = 0; ii < 2; ++ii) {
      const int it = half * 2 + ii;
      const int arow = dir ? 63 - (it * 16 + l15) : it * 16 + l15;
      bf16x8 ak[2], aq[2];
#pragma unroll
      for (int ks = 0; ks < 2; ++ks) {
        ak[ks] = *(const bf16x8*)(sK + arow * 72 + ks * 32 + g * 8);
        aq[ks] = *(const bf16x8*)(sQ + arow * 72 + ks * 32 + g * 8);
      }
#pragma unroll
      for (int jt = 0; jt < 4; ++jt) {
        const int brow = dir ? 63 - (jt * 16 + l15) : jt * 16 + l15;
        f32x4 kk = f32x4{0.f, 0.f, 0.f, 0.f}, qk = f32x4{0.f, 0.f, 0.f, 0.f};
#pragma unroll
        for (int ks = 0; ks < 2; ++ks) {
          const bf16x8 bk = *(const bf16x8*)(sK + brow * 72 + ks * 32 + g * 8);
          kk = MFMA16(ak[ks], bk, kk);
          qk = MFMA16(aq[ks], bk, qk);
        }
        const int jp = jt * 16 + l15;
        const float gj = gc[jp];
#pragma unroll
        for (int rr = 0; rr < 4; ++rr) {
          const int ip = it * 16 + g * 4 + rr;
          const float dec = __expf(fminf(gc[ip] - gj, 0.f));
          Ld[ip * 72 + jp] = (ip > jp) ? sBeta[dir * 64 + ip] * kk[rr] * dec : 0.f;
          dAQK[ip * 64 + jp] = (u16)f2bf((ip >= jp) ? qk[rr] * dec : 0.f);
        }
      }
    }
  }
  {
    const int hd = tid & 127;
    const int ip = hd & 63, dh = hd >> 6;
    const int srow = dir ? 63 - ip : ip;
    const float eg = __expf(gc[ip]);
    const float ef = __expf(gc[63] - gc[ip]);
#pragma unroll
    for (int d8 = 0; d8 < 4; ++d8) {
      float qv[8];
      unpack8(*(const uint4*)(sQ + srow * 72 + dh * 32 + d8 * 8), qv);
      *(uint4*)(dQG + ip * 64 + dh * 32 + d8 * 8) = uint4{pack2bf(qv[0] * eg, qv[1] * eg), pack2bf(qv[2] * eg, qv[3] * eg), pack2bf(qv[4] * eg, qv[5] * eg), pack2bf(qv[6] * eg, qv[7] * eg)};
      float kv[8];
      unpack8(*(const uint4*)(sK + srow * 72 + dh * 32 + d8 * 8), kv);
#pragma unroll
      for (int j = 0; j < 8; ++j) dKT[(dh * 32 + d8 * 8 + j) * 64 + ip] = (u16)f2bf(kv[j] * ef);
    }
    if (hd == 0) ((float*)(p.ws + OFF_GL))[dir * 1280 + cid] = __expf(gc[63]);
  }
  __syncthreads();
  if (half == 0) {
    const float* Ld = sL + dir * 4608;
    float T[64];
#pragma unroll
    for (int i = 0; i < 64; ++i) {
      float t = (i == lane) ? 1.f : 0.f;
#pragma unroll
      for (int j4 = 0; j4 < (i + 3) / 4; ++j4) {
        const float4 lv = *(const float4*)(Ld + i * 72 + j4 * 4);
        if (j4 * 4 + 0 < i) t -= lv.x * T[j4 * 4 + 0];
        if (j4 * 4 + 1 < i) t -= lv.y * T[j4 * 4 + 1];
        if (j4 * 4 + 2 < i) t -= lv.z * T[j4 * 4 + 2];
        if (j4 * 4 + 3 < i) t -= lv.w * T[j4 * 4 + 3];
      }
      T[i] = t;
      if ((i & 3) == 3) __builtin_amdgcn_sched_barrier(0);
    }
    const float bc = sBeta[dir * 64 + lane];
    const float bg = bc * __expf(gc[lane]);
    u16* Tb = (u16*)(sL + dir * 4608);
    u16* Tbg = Tb + 4608;
#pragma unroll
    for (int i = 0; i < 64; ++i) {
      Tb[i * 72 + lane] = (u16)f2bf(T[i] * bc);
      Tbg[i * 72 + lane] = (u16)f2bf(T[i] * bg);
    }
  }
  __syncthreads();
  {
    const u16* Tb = (const u16*)(sL + dir * 4608);
    const u16* Tbg = Tb + 4608;
#pragma unroll
    for (int ii = 0; ii < 2; ++ii) {
      const int pt = half * 2 + ii;
      bf16x8 ab[2], abg[2];
#pragma unroll
      for (int ks = 0; ks < 2; ++ks) {
        ab[ks] = *(const bf16x8*)(Tb + (pt * 16 + l15) * 72 + ks * 32 + g * 8);
        abg[ks] = *(const bf16x8*)(Tbg + (pt * 16 + l15) * 72 + ks * 32 + g * 8);
      }
#pragma unroll
      for (int dt = 0; dt < 4; ++dt) {
        f32x4 uu = f32x4{0.f, 0.f, 0.f, 0.f}, ww = f32x4{0.f, 0.f, 0.f, 0.f};
#pragma unroll
        for (int ks = 0; ks < 2; ++ks) {
          bf16x8 bv, bk;
#pragma unroll
          for (int j = 0; j < 8; ++j) {
            const int jp = ks * 32 + g * 8 + j;
            const int srow = dir ? 63 - jp : jp;
            bv[j] = (short)sV[srow * 72 + dt * 16 + l15];
            bk[j] = (short)sK[srow * 72 + dt * 16 + l15];
          }
          uu = MFMA16(ab[ks], bv, uu);
          ww = MFMA16(abg[ks], bk, ww);
        }
#pragma unroll
        for (int rr = 0; rr < 4; ++rr) {
          const int ip = pt * 16 + g * 4 + rr;
          dU[ip * 64 + dt * 16 + l15] = (u16)f2bf(uu[rr]);
          dW[ip * 64 + dt * 16 + l15] = (u16)f2bf(ww[rr]);
        }
      }
    }
  }
  __syncthreads();
}

DI void phase_prep(char* smem, const Params& p, int l, int r, int bid, int nb) {
  for (int it = bid; it < 1280 + 320 + 64 + 2560; it += nb) {
#ifndef NO_DELTA
    if (it < 1280) prep_delta_item(smem, p, l, r, it);
#else
    if (it < 1280) {}
#endif
#ifndef NO_PATTN
    else if (it < 1600) prep_attn_item(p, l, r, it - 1280);
#endif
    else if (it < 1664) prep_cache_item(p, l, r, it - 1600);
    else prep_convb_item(p, l, r, it - 1664);
  }
}

DI void scan_item(char* smem, const Params& p, int l, int r, int dir, bool lat, int chain) {
  const int bl = chain >> 2, h = chain & 3;
  const int NC = lat ? 64 : 4;
  const int tid = opaque_tid(), lane = tid & 63, w = tid >> 6, l15 = lane & 15, g = lane >> 4;
  u16* sW = (u16*)smem;
  u16* sQG = sW + 4608, *sAQK = sW + 9216, *sKT = sW + 13824, *sU = sW + 18432;
  const int cid0 = lat ? 256 + chain * 64 : chain * 4;
  const char* dnbase = p.ws + OFF_DN + (size_t)(dir * 1280 + cid0) * 40960;
  const float* GL = (const float*)(p.ws + OFF_GL) + dir * 1280 + cid0;
  u16* O = (u16*)(p.ws + OFF_ODIR) + (size_t)dir * TR * 256;
  const int useq = lat ? 4096 + bl * 4096 : bl * 256;
  const int dv = w * 16 + l15;
  f32x4 S[4];
  if (lat) {
    const int b = r * 4 + bl;
    const float* s0 = p.state_delta + (size_t)(((b * 2 + l) * 2 + dir) * 4 + h) * 4096;
#pragma unroll
    for (int t = 0; t < 4; ++t)
#pragma unroll
      for (int rr = 0; rr < 4; ++rr) S[t][rr] = s0[(t * 16 + g * 4 + rr) * 64 + dv];
  } else {
#pragma unroll
    for (int t = 0; t < 4; ++t) S[t] = f32x4{0.f, 0.f, 0.f, 0.f};
  }
#define REP10(X) X(0) X(1) X(2) X(3) X(4) X(5) X(6) X(7) X(8) X(9)
#define PRE_DECL(i) uint4 pre##i = *(const uint4*)(dnbase + (size_t)(tid + i * 256) * 16);
  REP10(PRE_DECL)
  float gl = GL[0];
  for (int n = 0; n < NC; ++n) {
    __syncthreads();
#define PRE_ST(i) { const int c = tid + i * 256; const int mat = c >> 9, row = (c >> 3) & 63, kc = c & 7; *(uint4*)(sW + mat * 4608 + row * 72 + kc * 8) = pre##i; }
    REP10(PRE_ST)
    const float glc = gl;
    __syncthreads();
    if (n + 1 < NC) {
      const char* nb_ = dnbase + (size_t)(n + 1) * 40960;
#define PRE_LD(i) pre##i = *(const uint4*)(nb_ + (size_t)(tid + i * 256) * 16);
      REP10(PRE_LD)
      gl = GL[n + 1];
    }
    bf16x8 Sb[2], Sn[2];
#pragma unroll
    for (int ks = 0; ks < 2; ++ks) {
      Sb[ks] = pack8(S[2 * ks], S[2 * ks + 1]);
#pragma unroll
      for (int j = 0; j < 8; ++j) Sn[ks][j] = (short)(Sb[ks][j] ^ (short)0x8000);
    }
    f32x4 vn[4];
#pragma unroll
    for (int pt = 0; pt < 4; ++pt) {
#pragma unroll
      for (int rr = 0; rr < 4; ++rr) vn[pt][rr] = bf2f(sU[(pt * 16 + g * 4 + rr) * 72 + dv]);
#pragma unroll
      for (int ks = 0; ks < 2; ++ks) vn[pt] = MFMA16(frag_perm(sW, pt * 16 + l15, ks, g), Sn[ks], vn[pt]);
      __builtin_amdgcn_sched_barrier(0);
    }
    __builtin_amdgcn_sched_barrier(0);
    bf16x8 Vb[2];
#pragma unroll
    for (int ks = 0; ks < 2; ++ks) Vb[ks] = pack8(vn[2 * ks], vn[2 * ks + 1]);
    const int norig = dir ? NC - 1 - n : n;
#pragma unroll
    for (int pt = 0; pt < 4; ++pt) {
      f32x4 o = f32x4{0.f, 0.f, 0.f, 0.f};
#pragma unroll
      for (int ks = 0; ks < 2; ++ks) {
        o = MFMA16(frag_perm(sQG, pt * 16 + l15, ks, g), Sb[ks], o);
        o = MFMA16(frag_perm(sAQK, pt * 16 + l15, ks, g), Vb[ks], o);
      }
#pragma unroll
      for (int rr = 0; rr < 4; ++rr) {
        const int ip = pt * 16 + g * 4 + rr;
        const int i = dir ? 63 - ip : ip;
        O[(size_t)(useq + norig * 64 + i) * 256 + h * 64 + dv] = (u16)f2bf(o[rr]);
      }
      __builtin_amdgcn_sched_barrier(0);
    }
#pragma unroll
    for (int t = 0; t < 4; ++t) {
      S[t] = S[t] * glc;
#pragma unroll
      for (int ks = 0; ks < 2; ++ks) S[t] = MFMA16(frag_perm(sKT, t * 16 + l15, ks, g), Vb[ks], S[t]);
    }
  }
  if (!lat) {
    const int b = r * 16 + bl;
    float* so = p.out + OUT_S + (size_t)(((b * 2 + l) * 2 + dir) * 4 + h) * 4096;
#pragma unroll
    for (int t = 0; t < 4; ++t)
#pragma unroll
      for (int rr = 0; rr < 4; ++rr) so[(t * 16 + g * 4 + rr) * 64 + dv] = S[t][rr];
  }
  __syncthreads();
}

DI void attn_item(char* smem, const Params& p, int r, bool lat, int item) {
  int bl, hq, qb;
  if (lat) { bl = item >> 7; hq = (item >> 5) & 3; qb = item & 31; } else { bl = item >> 3; hq = (item >> 1) & 3; qb = item & 1; }
  const int kvh = hq >> 1;
  const int Lk = lat ? 4608 : 256;
  const int useq = lat ? 4096 + bl * 4096 : bl * 256;
  const u16* Kb = lat ? (const u16*)(p.ws + OFF_KBL) + (size_t)(bl * 2 + kvh) * 4608 * 64 : (const u16*)(p.ws + OFF_KBC) + (size_t)(bl * 2 + kvh) * 256 * 64;
  const u16* Vt = lat ? (const u16*)(p.ws + OFF_VTL) + (size_t)(bl * 2 + kvh) * 64 * 4608 : (const u16*)(p.ws + OFF_VTC) + (size_t)(bl * 2 + kvh) * 64 * 256;
  const u16* Qb = (const u16*)(p.ws + OFF_QB);
  const int tid = opaque_tid(), lane = tid & 63, w = tid >> 6, l15 = lane & 15, g = lane >> 4;
  u16* sK = (u16*)smem;
  u16* sV = (u16*)(smem + 18432);
  const int uq0 = useq + qb * 128 + w * 32;
  bf16x8 qf[2][2];
#pragma unroll
  for (int qt = 0; qt < 2; ++qt)
#pragma unroll
    for (int ks = 0; ks < 2; ++ks) qf[qt][ks] = *(const bf16x8*)(Qb + ((size_t)(uq0 + qt * 16 + l15) * 4 + hq) * 64 + ks * 32 + g * 8);
  f32x4 oacc[4][2];
#pragma unroll
  for (int dt = 0; dt < 4; ++dt)
#pragma unroll
    for (int qt = 0; qt < 2; ++qt) oacc[dt][qt] = f32x4{0.f, 0.f, 0.f, 0.f};
  float mrun[2] = {-1e30f, -1e30f}, lrun[2] = {0.f, 0.f};
  const int NT = Lk >> 6;
  uint4 pre[4];
  auto gload = [&](int kt) {
#pragma unroll
    for (int i = 0; i < 4; ++i) {
      const int c = tid + i * 256;
      const int row = (c >> 3) & 63, kc = c & 7;
      pre[i] = (c < 512) ? *(const uint4*)(Kb + (size_t)(kt * 64 + row) * 64 + kc * 8) : *(const uint4*)(Vt + (size_t)row * Lk + kt * 64 + kc * 8);
    }
  };
  auto sstore = [&](int buf) {
#pragma unroll
    for (int i = 0; i < 4; ++i) {
      const int c = tid + i * 256;
      const int row = (c >> 3) & 63, kc = c & 7;
      u16* d = (c < 512 ? sK : sV) + buf * 4608 + row * 72 + kc * 8;
      *(uint4*)d = pre[i];
    }
  };
  gload(0);
  sstore(0);
  __syncthreads();
  for (int kt = 0; kt < NT; ++kt) {
    const int buf = kt & 1;
    if (kt + 1 < NT) gload(kt + 1);
    const u16* cK = sK + buf * 4608;
    const u16* cV = sV + buf * 4608;
    f32x4 sacc[4][2];
#pragma unroll
    for (int k4 = 0; k4 < 4; ++k4) {
      bf16x8 kf[2];
#pragma unroll
      for (int ks = 0; ks < 2; ++ks) kf[ks] = *(const bf16x8*)(cK + (k4 * 16 + l15) * 72 + ks * 32 + g * 8);
#pragma unroll
      for (int qt = 0; qt < 2; ++qt) {
        f32x4 a = f32x4{0.f, 0.f, 0.f, 0.f};
        a = MFMA16(kf[0], qf[qt][0], a);
        a = MFMA16(kf[1], qf[qt][1], a);
        sacc[k4][qt] = a;
      }
    }
    bf16x8 pb[2][2];
#pragma unroll
    for (int qt = 0; qt < 2; ++qt) {
      float mx = -1e30f;
#pragma unroll
      for (int k4 = 0; k4 < 4; ++k4)
#pragma unroll
        for (int rr = 0; rr < 4; ++rr) mx = fmaxf(mx, sacc[k4][qt][rr]);
      mx = fmaxf(mx, __shfl_xor(mx, 16));
      mx = fmaxf(mx, __shfl_xor(mx, 32));
      const float mnew = fmaxf(mrun[qt], mx);
      const float alpha = __expf(mrun[qt] - mnew);
      mrun[qt] = mnew;
      float ps = 0.f;
#pragma unroll
      for (int k4 = 0; k4 < 4; ++k4)
#pragma unroll
        for (int rr = 0; rr < 4; ++rr) {
          const float e = __expf(sacc[k4][qt][rr] - mnew);
          sacc[k4][qt][rr] = e;
          ps += e;
        }
      lrun[qt] = lrun[qt] * alpha + ps;
#pragma unroll
      for (int dt = 0; dt < 4; ++dt) oacc[dt][qt] = oacc[dt][qt] * alpha;
      pb[qt][0] = pack8(sacc[0][qt], sacc[1][qt]);
      pb[qt][1] = pack8(sacc[2][qt], sacc[3][qt]);
    }
#pragma unroll
    for (int dt = 0; dt < 4; ++dt)
#pragma unroll
      for (int ks = 0; ks < 2; ++ks) {
        const bf16x8 vf = frag_perm(cV, dt * 16 + l15, ks, g);
#pragma unroll
        for (int qt = 0; qt < 2; ++qt) oacc[dt][qt] = MFMA16(vf, pb[qt][ks], oacc[dt][qt]);
      }
    if (kt + 1 < NT) sstore(buf ^ 1);
    __syncthreads();
  }
  u16* M = (u16*)(p.ws + OFF_H);
#pragma unroll
  for (int qt = 0; qt < 2; ++qt) {
    float lt = lrun[qt];
    lt += __shfl_xor(lt, 16);
    lt += __shfl_xor(lt, 32);
    const float inv = 1.f / lt;
    const int u = uq0 + qt * 16 + l15;
    u16* dst = M + (size_t)grow_of(u, r) * 1024 + hq * 64 + g * 4;
#pragma unroll
    for (int dt = 0; dt < 4; ++dt) {
      const f32x4 o = oacc[dt][qt];
      *(uint2*)(dst + dt * 16) = uint2{pack2bf(o[0] * inv, o[1] * inv), pack2bf(o[2] * inv, o[3] * inv)};
    }
  }
}

DI void fourier_item(char* smem, const Params& p, int r, bool lat, int item) {
  int bl, mt, nt;
  if (lat) { bl = item >> 6; mt = (item >> 1) & 31; nt = item & 1; } else { bl = item >> 2; mt = (item >> 1) & 1; nt = item & 1; }
  const int L = lat ? 4096 : 256;
  const u16* A = (const u16*)(p.ws + (lat ? OFF_DFTL : OFF_DFTC)) + (size_t)mt * 128 * 2 * L;
  const u16* Bt = (const u16*)(p.ws + (lat ? OFF_XTL : OFF_XTC)) + (size_t)(bl * 256 + nt * 128) * 2 * L;
  const int useq = lat ? 4096 + bl * 4096 : bl * 256;
  const float scale = lat ? (1.f / 512.f) : (1.f / 128.f);
  u16* M = (u16*)(p.ws + OFF_H);
  auto epi = [&](int ml, int nl, int i, int j, f32x4 (*acc)[4]) {
    const int u = useq + mt * 128 + ml;
    const f32x4 a = acc[i][j];
    *(uint2*)(M + (size_t)grow_of(u, r) * 1024 + 768 + nt * 128 + nl) = uint2{pack2bf(a[0] * scale, a[1] * scale), pack2bf(a[2] * scale, a[3] * scale)};
  };
  gemm_tile(smem, A, 2 * L, Bt, 2 * L, 2 * L, epi);
}

DI void phase_mix(char* smem, const Params& p, int l, int r, int bid, int nb) {
  for (int it = bid; it < 32 + 256 + 512 + 128 + 128 + 64; it += nb) {
#ifndef NO_SCAN
    if (it < 32) scan_item(smem, p, l, r, it >> 4, true, it & 15);
#else
    if (it < 32) {}
#endif
    else if (it < 288) fourier_item(smem, p, r, true, it - 32);
#ifndef NO_ATTN
    else if (it < 800) attn_item(smem, p, r, true, it - 288);
    else if (it < 928) attn_item(smem, p, r, false, it - 800);
#endif
#ifndef NO_SCAN
    else if (it < 1056) { const int j = it - 928; scan_item(smem, p, l, r, j >> 6, false, j & 63); }
#endif
    else fourier_item(smem, p, r, false, it - 1056);
  }
}

DI void phase_post(const Params& p, int l, int r, int bid, int nb) {
  const u16* O0 = (const u16*)(p.ws + OFF_ODIR);
  const u16* O1 = O0 + (size_t)TR * 256;
  const u16* P = (const u16*)(p.ws + OFF_P);
  u16* M = (u16*)(p.ws + OFF_H);
  for (int it = bid; it < TR * 16 / 256; it += nb) {
    const int idx = it * 256 + threadIdx.x;
    const int u = idx >> 4, h = (idx >> 2) & 3, q4 = idx & 3;
    const int c0 = h * 64 + q4 * 16;
    float a[16], b[16], z[16];
    unpack8(*(const uint4*)(O0 + (size_t)u * 256 + c0), a);
    unpack8(*(const uint4*)(O0 + (size_t)u * 256 + c0 + 8), a + 8);
    unpack8(*(const uint4*)(O1 + (size_t)u * 256 + c0), b);
    unpack8(*(const uint4*)(O1 + (size_t)u * 256 + c0 + 8), b + 8);
    unpack8(*(const uint4*)(P + (size_t)u * PW + 2048 + c0), z);
    unpack8(*(const uint4*)(P + (size_t)u * PW + 2048 + c0 + 8), z + 8);
    float ss = 0.f;
#pragma unroll
    for (int j = 0; j < 16; ++j) { a[j] += b[j]; ss += a[j] * a[j]; }
    ss += __shfl_xor(ss, 1);
    ss += __shfl_xor(ss, 2);
    const float rstd = rsqrtf(ss * (1.f / 64.f) + 1e-6f);
    float o[16];
#pragma unroll
    for (int j = 0; j < 16; ++j) o[j] = a[j] * rstd * p.delta_norm[l * 64 + q4 * 16 + j] * siluf(z[j]);
    u16* dst = M + (size_t)grow_of(u, r) * 1024 + 512 + c0;
    *(uint4*)dst = uint4{pack2bf(o[0], o[1]), pack2bf(o[2], o[3]), pack2bf(o[4], o[5]), pack2bf(o[6], o[7])};
    *(uint4*)(dst + 8) = uint4{pack2bf(o[8], o[9]), pack2bf(o[10], o[11]), pack2bf(o[12], o[13]), pack2bf(o[14], o[15])};
  }
}

DI void run_phase(char* smem, const Params& p, int ph, int l, int a, int bid, int nb) {
  switch (ph) {
    case 0: phase_init(smem, p, bid, nb); break;
    case 1: phase_norm(p, l, a, bid, nb); break;
    case 2: phase_up(smem, p, l, a, bid, nb); break;
    case 3: phase_resid(smem, p, (const u16*)(p.ws + OFF_ACT), 2816, (const u16*)(p.ws + OFF_DNT + (size_t)(l * 2 + a) * SZ_DNT), 2816, l, a ? 8 : 2, 0.5f, l == 0 && a == 0, bid, nb); break;
    case 4: phase_proj(smem, p, l, a, bid, nb); break;
    case 5: phase_prep(smem, p, l, a, bid, nb); break;
    case 6: phase_mix(smem, p, l, a, bid, nb); break;
    case 7: phase_post(p, l, a, bid, nb); break;
    case 8: phase_resid(smem, p, (const u16*)(p.ws + OFF_H), 1024, (const u16*)(p.ws + OFF_OUTT + (size_t)l * SZ_OUTT), 1024, l, 5, 1.f, false, bid, nb); break;
    default: phase_final(p, bid, nb); break;
  }
}

struct Step { int ph, l, a; };
__host__ __device__ inline int build_program(Step* s) {
  int n = 0;
  auto add = [&](int ph, int l, int a) { if (s) { s[n].ph = ph; s[n].l = l; s[n].a = a; } ++n; };
  add(0, 0, 0);
  for (int l = 0; l < 2; ++l) {
    add(1, l, 0); add(2, l, 0); add(3, l, 0);
    add(1, l, 1);
    for (int r = 0; r < 2; ++r) { add(4, l, r); add(5, l, r); add(6, l, r); add(7, l, r); }
    add(8, l, 0);
    add(1, l, 2); add(2, l, 1); add(3, l, 1);
  }
  add(9, 0, 0);
  return n;
}

template <int PH>
__global__ void __launch_bounds__(256, 2) k_phase(Params p, int l, int a) {
  extern __shared__ __attribute__((aligned(16))) char smem[];
  if (a == 0) run_phase(smem, p, PH, l, 0, blockIdx.x, gridDim.x);
  else if (a == 1) run_phase(smem, p, PH, l, 1, blockIdx.x, gridDim.x);
  else run_phase(smem, p, PH, l, 2, blockIdx.x, gridDim.x);
}
typedef void (*phase_fn)(Params, int, int);
static phase_fn phase_table[10] = {k_phase<0>, k_phase<1>, k_phase<2>, k_phase<3>, k_phase<4>, k_phase<5>, k_phase<6>, k_phase<7>, k_phase<8>, k_phase<9>};

__global__ void __launch_bounds__(256, 2) k_mega(Params p) {
  extern __shared__ __attribute__((aligned(16))) char smem[];
  cg::grid_group grid = cg::this_grid();
  const int bid = blockIdx.x, nb = gridDim.x;
  run_phase(smem, p, 0, 0, 0, bid, nb);
  grid.sync();
  for (int l = 0; l < 2; ++l) {
    run_phase(smem, p, 1, l, 0, bid, nb); grid.sync();
    run_phase(smem, p, 2, l, 0, bid, nb); grid.sync();
    run_phase(smem, p, 3, l, 0, bid, nb); grid.sync();
    run_phase(smem, p, 1, l, 1, bid, nb); grid.sync();
    for (int r = 0; r < 2; ++r) {
      run_phase(smem, p, 4, l, r, bid, nb); grid.sync();
      run_phase(smem, p, 5, l, r, bid, nb); grid.sync();
      run_phase(smem, p, 6, l, r, bid, nb); grid.sync();
      run_phase(smem, p, 7, l, r, bid, nb); grid.sync();
    }
    run_phase(smem, p, 8, l, 0, bid, nb); grid.sync();
    run_phase(smem, p, 1, l, 2, bid, nb); grid.sync();
    run_phase(smem, p, 2, l, 1, bid, nb); grid.sync();
    run_phase(smem, p, 3, l, 1, bid, nb); grid.sync();
  }
  run_phase(smem, p, 9, 0, 0, bid, nb);
}

extern "C" void kernel_launch(void* const* d_in, const int* in_sizes, int n_in, void* d_out, int out_size, void* d_ws, size_t ws_size, hipStream_t stream) {
  static int grid_blocks = 0;
  if (grid_blocks == 0) {
    if (ws_size < WS_END) { fprintf(stderr, "kernel_launch: workspace too small: %zu < %zu\n", ws_size, (size_t)WS_END); grid_blocks = -1; return; }
    int dev = 0, cus = 0, per_cu = 0;
    hipGetDevice(&dev);
    hipDeviceGetAttribute(&cus, hipDeviceAttributeMultiprocessorCount, dev);
    hipFuncSetAttribute((const void*)k_mega, hipFuncAttributeMaxDynamicSharedMemorySize, LDS_BYTES);
    for (int i = 0; i < 10; ++i) hipFuncSetAttribute((const void*)phase_table[i], hipFuncAttributeMaxDynamicSharedMemorySize, LDS_BYTES);
    hipOccupancyMaxActiveBlocksPerMultiprocessor(&per_cu, (const void*)k_mega, 256, LDS_BYTES);
    if (per_cu < 1) per_cu = 1;
    if (per_cu > 2) per_cu = 2;
    grid_blocks = cus * per_cu;
  }
  if (grid_blocks < 0) return;
  Params p{};
  const float** pf = (const float**)&p;
  for (int i = 0; i < 28; ++i) pf[i] = (const float*)d_in[i];
  p.out = (float*)d_out;
  p.ws = (char*)d_ws;
#if MULTI_LAUNCH
  Step prog[64];
  const int n = build_program(prog);
  for (int i = 0; i < n; ++i) hipLaunchKernelGGL(phase_table[prog[i].ph], dim3(grid_blocks), dim3(256), LDS_BYTES, stream, p, prog[i].l, prog[i].a);
#else
  void* args[] = {&p};
  hipError_t e = hipLaunchCooperativeKernel((const void*)k_mega, dim3(grid_blocks), dim3(256), args, LDS_BYTES, stream);
  if (e != hipSuccess) fprintf(stderr, "cooperative launch failed: %s (grid %d)\n", hipGetErrorString(e), grid_blocks);
#endif
}
```

```cpp
#include <hip/hip_runtime.h>
#include <hip/hip_cooperative_groups.h>
#include <stdint.h>
#include <stdio.h>
namespace cg = cooperative_groups;

#ifndef MULTI_LAUNCH
#define MULTI_LAUNCH 0
#endif

typedef unsigned short u16;
using bf16x8 = __attribute__((ext_vector_type(8))) short;
using s16x4 = __attribute__((ext_vector_type(4))) short;
using f32x4 = __attribute__((ext_vector_type(4))) float;
#define DI __device__ __forceinline__
#define MFMA16(a, b, c) __builtin_amdgcn_mfma_f32_16x16x32_bf16((a), (b), (c), 0, 0, 0)

constexpr int VSM = 73728;
constexpr int LDS_BYTES = 2 * VSM + 64;
constexpr int TR = 20480;
constexpr int PW = 2816;

constexpr size_t SZ_UPT = 5632ull * 1024 * 2;
constexpr size_t SZ_DNT = 1024ull * 2816 * 2;
constexpr size_t SZ_INT = 3072ull * 1024 * 2;
constexpr size_t SZ_OUTT = 1024ull * 1024 * 2;
constexpr size_t OFF_UPT = 0;
constexpr size_t OFF_DNT = OFF_UPT + 4 * SZ_UPT;
constexpr size_t OFF_INT = OFF_DNT + 4 * SZ_DNT;
constexpr size_t OFF_OUTT = OFF_INT + 2 * SZ_INT;
constexpr size_t OFF_MOD = OFF_OUTT + 2 * SZ_OUTT;
constexpr size_t OFF_ROPE = OFF_MOD + 663552;
constexpr size_t OFF_FFT = OFF_ROPE + 8192;
constexpr size_t OFF_DFTC = OFF_FFT + 65536;
constexpr size_t OFF_H = OFF_DFTC + 262144;
constexpr size_t OFF_X = OFF_H + 83886080;
constexpr size_t OFF_ACT = OFF_X;
constexpr size_t OFF_P = OFF_X;
constexpr size_t OFF_GATES = OFF_P + 115343360;
constexpr size_t OFF_XTC = OFF_GATES + 1310720;
constexpr size_t OFF_XTL = OFF_XTC + 4194304;
constexpr size_t OFF_QB = OFF_XTL + 16777216;
constexpr size_t OFF_KBC = OFF_QB + 10485760;
constexpr size_t OFF_KBL = OFF_KBC + 1048576;
constexpr size_t OFF_VTC = OFF_KBL + 4718592;
constexpr size_t OFF_VTL = OFF_VTC + 1048576;
constexpr size_t OFF_DN = OFF_VTL + 4718592;
constexpr size_t OFF_GL = OFF_DN + 104857600;
constexpr size_t OFF_ODIR = OFF_GL + 10240;
constexpr size_t OFF_CTR = OFF_ODIR + 20971520;
constexpr size_t OFF_BAR = OFF_CTR + 256;
constexpr size_t WS_END = OFF_BAR + 16384;

constexpr size_t OUT_K = 41943040;
constexpr size_t OUT_V = 44040192;
constexpr size_t OUT_S = 46137344;

struct Params {
  const float *x_prompt, *x_sample, *c, *cache_k, *cache_v, *state_delta, *c_ctx, *mod_w, *mod_b, *norm_ffn1, *norm_mix,
      *norm_ffn2, *ffn1_w1, *ffn1_w3, *ffn1_w2, *ffn2_w1, *ffn2_w3, *ffn2_w2, *w_in, *w_out, *q_norm, *k_norm, *conv_b_w,
      *conv_c_w, *delta_a_log, *delta_dt_bias, *delta_norm, *final_norm;
  float* out;
  char* ws;
};

DI int otid() { int t = threadIdx.x; asm volatile("" : "+v"(t)); return t; }
DI float sx(float v, int m) { const int idx = ((otid() & 63) ^ m) << 2; return __int_as_float(__builtin_amdgcn_ds_bpermute(idx, __float_as_int(v))); }
DI float sup(float v, int o) { const int idx = ((otid() & 63) - o) << 2; return __int_as_float(__builtin_amdgcn_ds_bpermute(idx, __float_as_int(v))); }
DI int opaque_tid() { int t = threadIdx.x & 255; asm volatile("" : "+v"(t)); return t; }
typedef float f32x2_t __attribute__((ext_vector_type(2)));
typedef __bf16 bf16x2_t __attribute__((ext_vector_type(2)));
DI unsigned cvtpk(float lo, float hi) { const f32x2_t v = {lo, hi}; const bf16x2_t b = __builtin_convertvector(v, bf16x2_t); return __builtin_bit_cast(unsigned, b); }
DI short f2bf(float x) { return (short)(cvtpk(x, 0.f) & 0xffffu); }
DI float bf2f(u16 b) { return __uint_as_float(((unsigned)b) << 16); }
DI unsigned pack2bf(float a, float b) { return cvtpk(a, b); }
DI float siluf(float x) { return x * __builtin_amdgcn_rcpf(1.f + __builtin_amdgcn_exp2f(-1.4426950408889634f * x)); }
DI bf16x8 pack8(f32x4 lo, f32x4 hi) {
  const uint4 v = uint4{cvtpk(lo[0], lo[1]), cvtpk(lo[2], lo[3]), cvtpk(hi[0], hi[1]), cvtpk(hi[2], hi[3])};
  return __builtin_bit_cast(bf16x8, v);
}
DI bf16x8 frag_perm(const u16* base, int row, int ks, int g) {
  const u16* q = base + row * 72 + ks * 32 + g * 4;
  s16x4 lo = *(const s16x4*)q;
  s16x4 hi = *(const s16x4*)(q + 16);
  return __builtin_shufflevector(lo, hi, 0, 1, 2, 3, 4, 5, 6, 7);
}
DI void unpack8(uint4 v, float* f) {
  f[0] = __uint_as_float(v.x << 16); f[1] = __uint_as_float(v.x & 0xffff0000u);
  f[2] = __uint_as_float(v.y << 16); f[3] = __uint_as_float(v.y & 0xffff0000u);
  f[4] = __uint_as_float(v.z << 16); f[5] = __uint_as_float(v.z & 0xffff0000u);
  f[6] = __uint_as_float(v.w << 16); f[7] = __uint_as_float(v.w & 0xffff0000u);
}
DI int grow_of(int u, int r) { return u < 4096 ? u + 4096 * r : u + 4096 + 16384 * r; }
DI int modv_of(int grow) { return grow < 8192 ? 0 : 1 + ((grow - 8192) >> 12); }

namespace pg8 {
#define PG8_LAS __attribute__((address_space(3)))
typedef unsigned short bf16_t;
typedef short bf16x8 __attribute__((ext_vector_type(8)));
typedef float f32x4 __attribute__((ext_vector_type(4)));
typedef unsigned u32x4 __attribute__((ext_vector_type(4)));
constexpr int BM = 256, BK = 64, HALF = 128, HTB = HALF * BK * 2  , STAGE_BYTES = 8 * HTB, NXCD = 8, WGM = 8;

__host__ __device__ __forceinline__ int lds_byte(int r, int c) { const int st = (r >> 4) * 2 + (c >> 5), rr = r & 15, cc = c & 31, ob = rr * 64 + cc * 2; return st * 1024 + (ob ^ (((ob >> 9) & 1) << 5)); }
__host__ __device__ __forceinline__ void stage_rc(int b, int& R, int& C) { const int st = b / 1024, sb = b % 1024, swz = sb ^ (((sb >> 9) & 1) << 5); R = (st >> 1) * 16 + swz / 64; C = (st & 1) * 32 + (swz % 64) / 2; }
__host__ __device__ __forceinline__ int perm32(int rho) { const int n = rho >> 4, i = rho & 15; return 8 * (i >> 2) + 4 * n + (i & 3); }

struct Unit { int pm, pn; };
struct Gemm { const bf16_t* A; const bf16_t* Bt; int M, N, K, ld; };

__device__ __forceinline__ unsigned cvt_pk_bf16(float lo, float hi) { unsigned r; asm volatile("v_cvt_pk_bf16_f32 %0, %1, %2" : "=v"(r) : "v"(lo), "v"(hi)); return r; }
template <class Epi, class Sched, bool STAMP = false>
__device__ __forceinline__ void gemm_phase(PG8_LAS unsigned char* lds, const Gemm g, const Sched& S, const Epi& E, unsigned long long* stamps) {
    int tid_ = threadIdx.x; asm volatile("" : "+v"(tid_));
    const int tid = tid_, wid = __builtin_amdgcn_readfirstlane(tid >> 6), lane = tid & 63, wr = wid >> 2, wc = wid & 3, fr = lane & 15, fq = lane >> 4;
    const int K = g.ld, nt = g.K / BK;
    int ts_lo = 0, ts_hi = 0, nts = 0; const unsigned long long rt_entry = STAMP ? (unsigned long long)wall_clock64() : 0ull;
#define PG8_STAMP() do { if (STAMP && wid == 0 && nts < 64) { const unsigned long long _c = (unsigned long long)clock64(); \
        ts_lo = (lane == nts) ? (int)(unsigned)_c : ts_lo; ts_hi = (lane == nts) ? (int)(unsigned)(_c >> 32) : ts_hi; ++nts; } } while (0)
    PG8_STAMP();
    unsigned voffA[2], voffB[2];
#pragma unroll
    for (int i = 0; i < 2; ++i) { int R, C; stage_rc(tid * 16 + i * 8192, R, C); const int Rb = Epi::PERM ? ((R & ~31) + perm32(R & 31)) : R;
        voffA[i] = (unsigned)(R * K + C) * 2u; voffB[i] = (unsigned)(Rb * K + C) * 2u; }
    const size_t kstep = (size_t)(BK * 2);
    const size_t hstep = (size_t)HALF * K * 2;
    const size_t tstep = 2 * hstep;
    const unsigned ldsw = (unsigned)wid * 1024u;
    const int aoff = lds_byte(wr * 64 + fr, fq * 8), boff = lds_byte(wc * 32 + fr, fq * 8);
#define PG8_SA(b, h) (((b) * 2 + (h)) * HTB)
#define PG8_SB(b, h) ((4 + (b) * 2 + (h)) * HTB)
#define PG8_STAGE(bufoff, gbase, voff) do { _Pragma("unroll") for (int _i = 0; _i < 2; ++_i) \
        __builtin_amdgcn_global_load_lds((const unsigned*)((const char*)(gbase) + (voff)[_i]), (PG8_LAS unsigned*)(lds + (bufoff) + ldsw + _i * 8192), 16, 0, 0); } while (0)
#define PG8_LDA(dst, b, h) do { _Pragma("unroll") for (int m = 0; m < 4; ++m) _Pragma("unroll") for (int k = 0; k < 2; ++k) dst[m][k] = *(const PG8_LAS bf16x8*)(lds + PG8_SA(b, h) + aoff + m * 2048 + k * 1024); } while (0)
#define PG8_LDB(dst, b, h) do { _Pragma("unroll") for (int n = 0; n < 2; ++n) _Pragma("unroll") for (int k = 0; k < 2; ++k) dst[n][k] = *(const PG8_LAS bf16x8*)(lds + PG8_SB(b, h) + boff + n * 2048 + k * 1024); } while (0)
#define PG8_MMA(ai, bj, At, Bt) do { __builtin_amdgcn_s_setprio(1); _Pragma("unroll") for (int m = 0; m < 4; ++m) _Pragma("unroll") for (int n = 0; n < 2; ++n) _Pragma("unroll") for (int k = 0; k < 2; ++k) \
        acc[ai][bj][m][n] = __builtin_amdgcn_mfma_f32_16x16x32_bf16(Bt[n][k], At[m][k], acc[ai][bj][m][n], 0, 0, 0); __builtin_amdgcn_s_setprio(0); } while (0)
#define PG8_WAIT_V(n) asm volatile("s_waitcnt vmcnt(" #n ")" ::: "memory")
#define PG8_WAIT_L(n) asm volatile("s_waitcnt lgkmcnt(" #n ")" ::: "memory")
#define PG8_BAR __builtin_amdgcn_s_barrier()
#define PG8_SCHED __builtin_amdgcn_sched_barrier(0)
    Unit cur, nxt; int ui = 0;
    if (!S.next(0, cur)) return;
    f32x4 acc[2][2][4][2];
#pragma unroll
    for (int a = 0; a < 2; ++a)
#pragma unroll
        for (int b = 0; b < 2; ++b)
#pragma unroll
            for (int m = 0; m < 4; ++m)
#pragma unroll
                for (int n = 0; n < 2; ++n) acc[a][b][m][n] = (f32x4){0.f, 0.f, 0.f, 0.f};
    bf16x8 At[4][2], B0[2][2], B1[2][2];
    const char* cA = (const char*)g.A + (size_t)cur.pm * tstep; const char* cB = (const char*)g.Bt + (size_t)cur.pn * tstep;
    S.a_ready(cur);
    PG8_STAGE(PG8_SB(0, 0), cB, voffB); PG8_STAGE(PG8_SA(0, 0), cA, voffA); PG8_STAGE(PG8_SB(0, 1), cB + hstep, voffB); PG8_STAGE(PG8_SA(0, 1), cA + hstep, voffA);
    if (wr == 1) PG8_BAR;
    PG8_WAIT_V(4); PG8_BAR;
    PG8_STAGE(PG8_SB(1, 0), cB + kstep, voffB); PG8_STAGE(PG8_SA(1, 0), cA + kstep, voffA); PG8_STAGE(PG8_SB(1, 1), cB + hstep + kstep, voffB);
    PG8_WAIT_V(6); PG8_BAR;
    PG8_STAMP();
    for (;;) {
        const bool has_next = S.next(ui + 1, nxt);
        const char* nA = has_next ? (const char*)g.A + (size_t)nxt.pm * tstep : cA; const char* nB = has_next ? (const char*)g.Bt + (size_t)nxt.pn * tstep : cB;
        for (int t = 0; t < nt; t += 2) {
            const bool last = (t == nt - 2);
            const char* a1 = cA + (size_t)(t + 1) * kstep;
            const char* a2 = last ? nA : cA + (size_t)(t + 2) * kstep; const char* b2 = last ? nB : cB + (size_t)(t + 2) * kstep;
            const char* a3 = a2 + kstep; const char* b3 = b2 + kstep;
            if (last && has_next) S.a_ready(nxt);
            PG8_LDB(B0, 0, 0); PG8_SCHED; PG8_LDA(At, 0, 0); PG8_STAGE(PG8_SA(1, 1), a1 + hstep, voffA);
            PG8_WAIT_L(8); PG8_BAR; PG8_WAIT_L(0); PG8_MMA(0, 0, At, B0); PG8_BAR; PG8_SCHED;
            PG8_LDB(B1, 0, 1); PG8_STAGE(PG8_SB(0, 0), b2, voffB);
            PG8_BAR; PG8_WAIT_L(0); PG8_MMA(0, 1, At, B1); PG8_BAR;
            PG8_LDA(At, 0, 1); PG8_STAGE(PG8_SA(0, 0), a2, voffA);
            PG8_BAR; PG8_WAIT_L(0); PG8_MMA(1, 0, At, B0); PG8_BAR; PG8_SCHED;
            PG8_STAGE(PG8_SB(0, 1), b2 + hstep, voffB);
            PG8_WAIT_V(6); PG8_BAR; PG8_MMA(1, 1, At, B1); PG8_BAR;
            PG8_LDB(B0, 1, 0); PG8_SCHED; PG8_LDA(At, 1, 0); PG8_STAGE(PG8_SA(0, 1), a2 + hstep, voffA);
            PG8_WAIT_L(8); PG8_BAR; PG8_WAIT_L(0); PG8_MMA(0, 0, At, B0); PG8_BAR; PG8_SCHED;
            PG8_LDB(B1, 1, 1); PG8_STAGE(PG8_SB(1, 0), b3, voffB);
            PG8_BAR; PG8_WAIT_L(0); PG8_MMA(0, 1, At, B1); PG8_BAR;
            PG8_LDA(At, 1, 1); PG8_STAGE(PG8_SA(1, 0), a3, voffA);
            PG8_BAR; PG8_WAIT_L(0); PG8_MMA(1, 0, At, B0); PG8_BAR; PG8_SCHED;
            PG8_STAGE(PG8_SB(1, 1), b3 + hstep, voffB);
            PG8_WAIT_V(6); PG8_BAR; PG8_MMA(1, 1, At, B1); PG8_BAR;
        }
        PG8_STAMP();
        if constexpr (!Epi::AFTER_DRAIN) { E(acc, cur, wr, wc, fr, fq); S.done(cur); }
        PG8_STAMP();
        if (!has_next) break;
#pragma unroll
        for (int a = 0; a < 2; ++a)
#pragma unroll
            for (int b = 0; b < 2; ++b)
#pragma unroll
                for (int m = 0; m < 4; ++m)
#pragma unroll
                    for (int n = 0; n < 2; ++n) acc[a][b][m][n] = (f32x4){0.f, 0.f, 0.f, 0.f};
        cur = nxt; cA = nA; cB = nB; ++ui;
    }
    PG8_WAIT_V(0);
    if (wr == 0) PG8_BAR;
    PG8_BAR;
    if constexpr (Epi::AFTER_DRAIN) { E.fused(acc, cur, wr, wc, fr, fq, lds, wid, lane); S.done(cur); }
    PG8_STAMP();
    if (STAMP && wid == 0) { stamps[lane] = lane < nts ? (((unsigned long long)(unsigned)ts_hi << 32) | (unsigned)ts_lo) : 0ull;
        if (lane == 62) stamps[62] = rt_entry; if (lane == 63) stamps[63] = (unsigned long long)wall_clock64(); }
#undef PG8_STAMP
#undef PG8_SA
#undef PG8_SB
#undef PG8_STAGE
#undef PG8_LDA
#undef PG8_LDB
#undef PG8_MMA
#undef PG8_WAIT_V
#undef PG8_WAIT_L
#undef PG8_BAR
#undef PG8_SCHED
}
}


struct OrderStd {
  int nM, nN, nwg, G, c, mode, r;
  DI void init(int nM_, int nN_, int G_, int c_, int mode_, int r_) { nM = nM_; nN = nN_; nwg = nM * nN; G = G_; c = c_; mode = mode_; r = r_; }
  DI bool next(int i, pg8::Unit& u) const {
    const long Lx = (long)i * G + c;
    if (Lx >= nwg) return false;
    int wgid = (int)Lx;
    { const int q = nwg / 8, rr = nwg % 8, xcd = wgid % 8, off = wgid / 8; wgid = (xcd < rr ? xcd * (q + 1) : rr * (q + 1) + (xcd - rr) * q) + off; }
    const int nig = 8 * nN, gid = wgid / nig, fm = gid * 8, gsz = (nM - fm) < 8 ? (nM - fm) : 8;
    u.pm = fm + ((wgid % nig) % gsz);
    u.pn = (wgid % nig) / gsz;
    if (mode == 1) u.pm = (u.pm < 16) ? u.pm + 16 * r : 32 + 64 * r + (u.pm - 16);
    return true;
  }
  DI void a_ready(const pg8::Unit&) const {}
  DI void done(const pg8::Unit&) const {}
};
struct OrderOne {
  int idx, count, mtiles;
  DI bool next(int i, pg8::Unit& u) const {
    if (i != 0 || idx < 0 || idx >= count) return false;
    u.pm = __builtin_amdgcn_readfirstlane(idx % mtiles);
    u.pn = __builtin_amdgcn_readfirstlane(idx / mtiles);
    return true;
  }
  DI void a_ready(const pg8::Unit&) const {}
  DI void done(const pg8::Unit&) const {}
};

DI int rowmap(int mode, int n) {
  if (mode == 0) return n;
  if (mode == 1) return (n >> 4) * 32 + (n & 15);
  if (mode == 2) return (n >> 4) * 32 + 16 + (n & 15);
  return 2816 + (n - 2304);
}
DI void transpose_item(char* smem, const float* __restrict__ W, int ldw, int k0, int n0, int nvalid, u16* dst, int ldd, int mode) {
  float* tile = (float*)smem;
  const int tid = opaque_tid(), tx = tid & 63, ty = tid >> 6;
  for (int r = ty; r < 64; r += 4) tile[r * 65 + tx] = (tx < nvalid) ? W[(size_t)(k0 + r) * ldw + n0 + tx] : 0.f;
  __syncthreads();
  const int n = tid >> 2, kq = tid & 3;
  if (n < nvalid) {
    unsigned pk[8];
#pragma unroll
    for (int j = 0; j < 8; ++j) pk[j] = pack2bf(tile[(kq * 16 + 2 * j) * 65 + n], tile[(kq * 16 + 2 * j + 1) * 65 + n]);
    u16* d = dst + (size_t)rowmap(mode, n0 + n) * ldd + k0 + kq * 16;
    *(uint4*)d = uint4{pk[0], pk[1], pk[2], pk[3]};
    *(uint4*)(d + 8) = uint4{pk[4], pk[5], pk[6], pk[7]};
  }
  __syncthreads();
}

DI void fold_item(char* smem, const Params& p, int l, int it) {
  float* tile = (float*)smem;
  float* trig = tile + 64 * 65;
  const int tid = opaque_tid(), tx = tid & 63, ty = tid >> 6;
  const int wg = it >> 4, which = wg >> 2, g = wg & 3, k0 = (it & 15) * 64;
  const float* W = p.w_in + (size_t)l * 1024 * 2576;
  for (int r = ty; r < 64; r += 4) tile[r * 65 + tx] = W[(size_t)(k0 + r) * 2576 + 2320 + g * 64 + tx];
  if (tid < 64) {
    float s, c;
    sincospif((float)tid / 32.f, &s, &c);
    trig[tid] = which ? s : c;
  }
  __syncthreads();
  const int kc = tid & 63, kq = tid >> 6;
  float acc[16];
#pragma unroll
  for (int j = 0; j < 16; ++j) acc[j] = 0.f;
  for (int cidx = 0; cidx < 64; ++cidx) {
    const float t = trig[(cidx * kc) & 63];
#pragma unroll
    for (int j = 0; j < 16; ++j) acc[j] += tile[(kq * 16 + j) * 65 + cidx] * t;
  }
  u16* dst = (u16*)(p.ws + OFF_INT + (size_t)l * SZ_INT) + (size_t)(2304 + which * 256 + g * 64 + kc) * 1024 + k0 + kq * 16;
  unsigned pk[8];
#pragma unroll
  for (int j = 0; j < 8; ++j) pk[j] = pack2bf(acc[2 * j], acc[2 * j + 1]);
  *(uint4*)dst = uint4{pk[0], pk[1], pk[2], pk[3]};
  *(uint4*)(dst + 8) = uint4{pk[4], pk[5], pk[6], pk[7]};
  __syncthreads();
}

DI void dft_row_item(const Params& p, int it) {
  const int L = 256;
  const int kL = it;
  u16* row = (u16*)(p.ws + OFF_DFTC) + (size_t)kL * 2 * L;
  const float inv = 2.f / (float)L;
  for (int cch = (otid() & 255); cch < L / 8; cch += 256) {
    unsigned pc[4], ps[4];
#pragma unroll
    for (int j = 0; j < 4; ++j) {
      float s0, c0, s1, c1;
      const int l0 = cch * 8 + 2 * j;
      sincospif((float)((kL * l0) & (L - 1)) * inv, &s0, &c0);
      sincospif((float)((kL * (l0 + 1)) & (L - 1)) * inv, &s1, &c1);
      pc[j] = pack2bf(c0, c1);
      ps[j] = pack2bf(-s0, -s1);
    }
    *(uint4*)(row + cch * 8) = uint4{pc[0], pc[1], pc[2], pc[3]};
    *(uint4*)(row + L + cch * 8) = uint4{ps[0], ps[1], ps[2], ps[3]};
  }
}

DI void rope_item(const Params& p, int it) {
  if (it >= 4) {
    const int e = (it - 4) * 256 + (otid() & 255);
    const int k = e >> 6, l = e & 63;
    float s, c;
    sincospif((float)((k * l) & 63) / 32.f, &s, &c);
    u16* CS = (u16*)(p.ws + OFF_FFT);
    CS[e] = (u16)f2bf(c);
    CS[4096 + e] = (u16)f2bf(s);
    float s2, c2;
    sincospif((float)(k * l) / 2048.f, &s2, &c2);
    float* TW = (float*)(p.ws + OFF_FFT + 16384);
    TW[e * 2] = c2;
    TW[e * 2 + 1] = s2;
    return;
  }
  const int e = it * 256 + (otid() & 255);
  const int pos = e >> 4, i = e & 15;
  const float inv_freq = powf(10000.f, -(float)i / 16.f);
  const float ang = (float)pos * inv_freq;
  float* rope = (float*)(p.ws + OFF_ROPE);
  rope[e * 2] = cosf(ang);
  rope[e * 2 + 1] = sinf(ang);
}

DI void mod_item(char* smem, const Params& p, int it) {
  const int l = it / 144, cb = it % 144, n0 = cb * 64;
  float* sc = (float*)smem;
  float* red = (float*)(smem + 36864);
  const int tid = opaque_tid();
  for (int e = tid; e < 9216; e += 256) {
    const int v = e >> 10, k = e & 1023;
    const float val = v == 0 ? p.c_ctx[k] : p.c[(v - 1) * 1024 + k];
    sc[e] = siluf(val);
  }
  __syncthreads();
  const int kg = tid >> 4, c4 = tid & 15;
  float acc[9][4];
#pragma unroll
  for (int v = 0; v < 9; ++v)
#pragma unroll
    for (int j = 0; j < 4; ++j) acc[v][j] = 0.f;
  const float* W = p.mod_w + (size_t)l * 1024 * 9216 + n0 + c4 * 4;
#pragma unroll 4
  for (int kk = 0; kk < 64; ++kk) {
    const int k = kg * 64 + kk;
    const float4 wv = *(const float4*)(W + (size_t)k * 9216);
#pragma unroll
    for (int v = 0; v < 9; ++v) {
      const float s = sc[v * 1024 + k];
      acc[v][0] += s * wv.x; acc[v][1] += s * wv.y; acc[v][2] += s * wv.z; acc[v][3] += s * wv.w;
    }
  }
#pragma unroll
  for (int v = 0; v < 9; ++v)
#pragma unroll
    for (int j = 0; j < 4; ++j) red[(kg * 9 + v) * 64 + c4 * 4 + j] = acc[v][j];
  __syncthreads();
  float* MOD = (float*)(p.ws + OFF_MOD);
  for (int e = tid; e < 576; e += 256) {
    const int v = e >> 6, cc = e & 63;
    float s = p.mod_b[l * 9216 + n0 + cc];
#pragma unroll
    for (int q = 0; q < 16; ++q) s += red[(q * 9 + v) * 64 + cc];
    MOD[(size_t)(l * 9 + v) * 9216 + n0 + cc] = s;
  }
  __syncthreads();
}

DI void phase_init(char* smem0, const Params& p, int bid0, int nb0) {
  constexpr int N_T = 10144, N_F = 256, N_D = 256, N_R = 20, N_M = 288;
  const int vb = otid() >> 8;
  char* smem = smem0 + vb * VSM;
  const int bid = bid0 * 2 + vb, nb = nb0 * 2;
  { const int t0 = otid(); if (bid0 == 0) { if (t0 < 64) ((int*)(p.ws + OFF_CTR))[t0] = 0; for (int i = t0; i < 3456; i += 512) ((unsigned*)(p.ws + OFF_BAR))[i] = 0u; } }
  for (int it = bid; it < N_T + N_F + N_D + N_R + N_M; it += nb) {
    if (it < N_T) {
      const int l = it / 5072, j = it % 5072;
      if (j < 4224) {
        const int f = j / 2112, jj = j % 2112, m = jj / 704, q = jj % 704;
        const float* w1 = (f ? p.ffn2_w1 : p.ffn1_w1) + (size_t)l * 1024 * 2816;
        const float* w3 = (f ? p.ffn2_w3 : p.ffn1_w3) + (size_t)l * 1024 * 2816;
        const float* w2 = (f ? p.ffn2_w2 : p.ffn1_w2) + (size_t)l * 2816 * 1024;
        if (m < 2) {
          u16* dst = (u16*)(p.ws + OFF_UPT + (size_t)(l * 2 + f) * SZ_UPT);
          transpose_item(smem, m ? w3 : w1, 2816, (q / 44) * 64, (q % 44) * 64, 64, dst, 1024, m ? 2 : 1);
        } else {
          u16* dst = (u16*)(p.ws + OFF_DNT + (size_t)(l * 2 + f) * SZ_DNT);
          transpose_item(smem, w2, 1024, (q / 16) * 64, (q % 16) * 64, 64, dst, 2816, 0);
        }
      } else if (j < 4816) {
        const int q = j - 4224, kt = q / 37, nt = q % 37;
        u16* dst = (u16*)(p.ws + OFF_INT + (size_t)l * SZ_INT);
        transpose_item(smem, p.w_in + (size_t)l * 1024 * 2576, 2576, kt * 64, nt * 64, nt < 36 ? 64 : 16, dst, 1024, nt < 36 ? 0 : 3);
      } else {
        const int q = j - 4816;
        u16* dst = (u16*)(p.ws + OFF_OUTT + (size_t)l * SZ_OUTT);
        transpose_item(smem, p.w_out + (size_t)l * 1024 * 1024, 1024, (q / 16) * 64, (q % 16) * 64, 64, dst, 1024, 0);
      }
    } else if (it < N_T + N_F) {
      const int j = it - N_T;
      fold_item(smem, p, j >> 7, j & 127);
    } else if (it < N_T + N_F + N_D) {
      dft_row_item(p, it - N_T - N_F);
    } else if (it < N_T + N_F + N_D + N_R) {
      rope_item(p, it - N_T - N_F - N_D);
    } else {
      mod_item(smem, p, it - N_T - N_F - N_D - N_R);
    }
  }
}

DI const float* xsrc_row(const Params& p, bool from_in, int grow) {
  if (from_in) return grow < 8192 ? p.x_prompt + (size_t)grow * 1024 : p.x_sample + (size_t)(grow - 8192) * 1024;
  return p.out + (size_t)grow * 1024;
}
DI float wave_sum(float v) {
#pragma unroll
  for (int o = 32; o > 0; o >>= 1) v += sx(v, o);
  return v;
}
DI void phase_norm(const Params& p, int l, int which, int bid, int nb) {
  const int t0 = otid(); const int lane = t0 & 63, w = t0 >> 6;
  const float* gain = (which == 0 ? p.norm_ffn1 : which == 1 ? p.norm_mix : p.norm_ffn2) + l * 1024;
  const float* MOD = (const float*)(p.ws + OFF_MOD);
  u16* H = (u16*)(p.ws + OFF_H);
  const bool from_in = (l == 0 && which == 0);
  const int stride = nb * 8;
  for (int row = bid * 8 + w; row < 40960; row += 2 * stride) {
    const int row2 = row + stride;
    const bool has2 = row2 < 40960;
    const float* xa = xsrc_row(p, from_in, row);
    const float* xb = xsrc_row(p, from_in, has2 ? row2 : row);
    float4 va[4], vb[4];
    float sa = 0.f, sb = 0.f;
#pragma unroll
    for (int i = 0; i < 4; ++i) { va[i] = *(const float4*)(xa + i * 256 + lane * 4); vb[i] = *(const float4*)(xb + i * 256 + lane * 4); }
#pragma unroll
    for (int i = 0; i < 4; ++i) {
      sa += va[i].x * va[i].x + va[i].y * va[i].y + va[i].z * va[i].z + va[i].w * va[i].w;
      sb += vb[i].x * vb[i].x + vb[i].y * vb[i].y + vb[i].z * vb[i].z + vb[i].w * vb[i].w;
    }
#pragma unroll
    for (int o = 32; o > 0; o >>= 1) { sa += sx(sa, o); sb += sx(sb, o); }
    const float ra = rsqrtf(sa * (1.f / 1024.f) + 1e-6f), rb = rsqrtf(sb * (1.f / 1024.f) + 1e-6f);
    const float* mva = MOD + (size_t)(l * 9 + modv_of(row)) * 9216 + which * 3 * 1024;
    const float* mvb = MOD + (size_t)(l * 9 + modv_of(has2 ? row2 : row)) * 9216 + which * 3 * 1024;
#pragma unroll
    for (int i = 0; i < 4; ++i) {
      const int k = i * 256 + lane * 4;
      const float4 gv = *(const float4*)(gain + k);
      {
        const float4 sh = *(const float4*)(mva + k);
        const float4 scv = *(const float4*)(mva + 1024 + k);
        const float h0 = va[i].x * ra * gv.x * (1.f + scv.x) + sh.x;
        const float h1 = va[i].y * ra * gv.y * (1.f + scv.y) + sh.y;
        const float h2 = va[i].z * ra * gv.z * (1.f + scv.z) + sh.z;
        const float h3 = va[i].w * ra * gv.w * (1.f + scv.w) + sh.w;
        *(uint2*)(H + (size_t)row * 1024 + k) = uint2{pack2bf(h0, h1), pack2bf(h2, h3)};
      }
      if (has2) {
        const float4 sh = *(const float4*)(mvb + k);
        const float4 scv = *(const float4*)(mvb + 1024 + k);
        const float h0 = vb[i].x * rb * gv.x * (1.f + scv.x) + sh.x;
        const float h1 = vb[i].y * rb * gv.y * (1.f + scv.y) + sh.y;
        const float h2 = vb[i].z * rb * gv.z * (1.f + scv.z) + sh.z;
        const float h3 = vb[i].w * rb * gv.w * (1.f + scv.w) + sh.w;
        *(uint2*)(H + (size_t)row2 * 1024 + k) = uint2{pack2bf(h0, h1), pack2bf(h2, h3)};
      }
    }
  }
}
DI void phase_final(const Params& p, int bid, int nb) {
  const int t0 = otid(); const int lane = t0 & 63, w = t0 >> 6;
  const int stride = nb * 8;
  for (int row = bid * 8 + w; row < 40960; row += 2 * stride) {
    const int row2 = row + stride;
    const bool has2 = row2 < 40960;
    float* xa = p.out + (size_t)row * 1024;
    float* xb = p.out + (size_t)(has2 ? row2 : row) * 1024;
    float4 va[4], vb[4];
    float sa = 0.f, sb = 0.f;
#pragma unroll
    for (int i = 0; i < 4; ++i) { va[i] = *(const float4*)(xa + i * 256 + lane * 4); vb[i] = *(const float4*)(xb + i * 256 + lane * 4); }
#pragma unroll
    for (int i = 0; i < 4; ++i) {
      sa += va[i].x * va[i].x + va[i].y * va[i].y + va[i].z * va[i].z + va[i].w * va[i].w;
      sb += vb[i].x * vb[i].x + vb[i].y * vb[i].y + vb[i].z * vb[i].z + vb[i].w * vb[i].w;
    }
#pragma unroll
    for (int o = 32; o > 0; o >>= 1) { sa += sx(sa, o); sb += sx(sb, o); }
    const float ra = rsqrtf(sa * (1.f / 1024.f) + 1e-6f), rb = rsqrtf(sb * (1.f / 1024.f) + 1e-6f);
#pragma unroll
    for (int i = 0; i < 4; ++i) {
      const int k = i * 256 + lane * 4;
      const float4 gv = *(const float4*)(p.final_norm + k);
      *(float4*)(xa + k) = float4{va[i].x * ra * gv.x, va[i].y * ra * gv.y, va[i].z * ra * gv.z, va[i].w * ra * gv.w};
      if (has2) *(float4*)(xb + k) = float4{vb[i].x * rb * gv.x, vb[i].y * rb * gv.y, vb[i].z * rb * gv.z, vb[i].w * rb * gv.w};
    }
  }
}

struct EpiUp {
  static constexpr bool PERM = false, AFTER_DRAIN = false;
  u16* ACT;
  DI void operator()(const f32x4 (&acc)[2][2][4][2], const pg8::Unit& u, int wr, int wc, int fr, int fq) const {
    const int row0 = u.pm * 256 + wr * 64 + fr;
#pragma unroll
    for (int ai = 0; ai < 2; ++ai)
#pragma unroll
      for (int m = 0; m < 4; ++m) {
        u16* rowp = ACT + (size_t)(row0 + ai * 128 + m * 16) * 2816 + 4 * fq;
#pragma unroll
        for (int bj = 0; bj < 2; ++bj) {
          const f32x4 a = acc[ai][bj][m][0], b = acc[ai][bj][m][1];
          const int col = (u.pn * 256 + bj * 128 + wc * 32) >> 1;
          *(uint2*)(rowp + col) = uint2{cvtpk(siluf(a[0]) * b[0], siluf(a[1]) * b[1]), cvtpk(siluf(a[2]) * b[2], siluf(a[3]) * b[3])};
        }
      }
  }
};
struct EpiResid {
  static constexpr bool PERM = false, AFTER_DRAIN = false;
  const float* xp; const float* xs; float* out; const float* gate;
  float coef; int from_in;
  DI void operator()(const f32x4 (&acc)[2][2][4][2], const pg8::Unit& u, int wr, int wc, int fr, int fq) const {
    const int row0 = u.pm * 256 + wr * 64 + fr, col0 = u.pn * 256 + wc * 32 + 4 * fq;
    const float* gv = gate + (size_t)modv_of(u.pm * 256) * 9216 + col0;
    f32x4 g4[2][2];
#pragma unroll
    for (int bj = 0; bj < 2; ++bj)
#pragma unroll
      for (int n = 0; n < 2; ++n) g4[bj][n] = *(const f32x4*)(gv + bj * 128 + n * 16) * coef;
#pragma unroll
    for (int ai = 0; ai < 2; ++ai)
#pragma unroll
      for (int m = 0; m < 4; ++m) {
        const int row = row0 + ai * 128 + m * 16;
        const float* xr = (from_in ? (row < 8192 ? xp + (size_t)row * 1024 : xs + (size_t)(row - 8192) * 1024) : out + (size_t)row * 1024) + col0;
        float* orow = out + (size_t)row * 1024 + col0;
#pragma unroll
        for (int bj = 0; bj < 2; ++bj)
#pragma unroll
          for (int n = 0; n < 2; ++n) {
            const f32x4 xv = *(const f32x4*)(xr + bj * 128 + n * 16);
            *(f32x4*)(orow + bj * 128 + n * 16) = xv + g4[bj][n] * acc[ai][bj][m][n];
          }
      }
  }
};
struct EpiProj {
  static constexpr bool PERM = false, AFTER_DRAIN = false;
  u16* P; float* GATES; u16* XTC; u16* XTL; int r;
  DI void operator()(const f32x4 (&acc)[2][2][4][2], const pg8::Unit& u, int wr, int wc, int fr, int fq) const {
    const int lt = u.pm < 32 ? u.pm - 16 * r : 16 + (u.pm - 32 - 64 * r);
    const int u0 = lt * 256 + wr * 64 + fr;
    if (u.pn < 9 || (u.pn < 11 && lt >= 16)) {
#pragma unroll
      for (int ai = 0; ai < 2; ++ai)
#pragma unroll
        for (int m = 0; m < 4; ++m) {
          u16* rowp = P + (size_t)(u0 + ai * 128 + m * 16) * PW + u.pn * 256 + wc * 32 + 4 * fq;
#pragma unroll
          for (int bj = 0; bj < 2; ++bj)
#pragma unroll
            for (int n = 0; n < 2; ++n) {
              const f32x4 a = acc[ai][bj][m][n];
              *(uint2*)(rowp + bj * 128 + n * 16) = uint2{cvtpk(a[0], a[1]), cvtpk(a[2], a[3])};
            }
        }
    } else if (u.pn < 11) {
      const int which = u.pn - 9;
      const bool isl = lt >= 16;
      const int ld = isl ? 8192 : 512;
      const int tl = isl ? lt - 16 : lt;
      const int bq = isl ? (tl >> 4) : tl;
      const int lp0 = isl ? (tl & 15) * 256 : 0;
      u16* d0 = (isl ? XTL : XTC) + (size_t)bq * 256 * ld + which * (ld >> 1) + lp0;
      const int lane_off = wr * 64 + fr + (wc * 32 + 4 * fq) * ld;
#pragma unroll
      for (int ai = 0; ai < 2; ++ai)
#pragma unroll
        for (int m = 0; m < 4; ++m)
#pragma unroll
          for (int bj = 0; bj < 2; ++bj)
#pragma unroll
            for (int n = 0; n < 2; ++n) {
              const f32x4 a = acc[ai][bj][m][n];
#pragma unroll
              for (int j = 0; j < 4; ++j) d0[lane_off + ai * 128 + m * 16 + (bj * 128 + n * 16 + j) * ld] = (u16)f2bf(a[j]);
            }
    } else {
      if (wc == 0) {
#pragma unroll
        for (int ai = 0; ai < 2; ++ai)
#pragma unroll
          for (int m = 0; m < 4; ++m) {
            const f32x4 a = acc[ai][0][m][0];
            *(f32x4*)(GATES + (size_t)(u0 + ai * 128 + m * 16) * 16 + 4 * fq) = a;
          }
      }
    }
  }
};
struct EpiFourier {
  static constexpr bool PERM = false, AFTER_DRAIN = false;
  u16* M; int r, lat; float scale;
  DI void operator()(const f32x4 (&acc)[2][2][4][2], const pg8::Unit& u, int wr, int wc, int fr, int fq) const {
    const int useq = lat ? 4096 + u.pn * 4096 : u.pn * 256;
    const int u0 = useq + u.pm * 256 + wr * 64 + fr;
#pragma unroll
    for (int ai = 0; ai < 2; ++ai)
#pragma unroll
      for (int m = 0; m < 4; ++m) {
        u16* rowp = M + (size_t)grow_of(u0 + ai * 128 + m * 16, r) * 1024 + 768 + wc * 32 + 4 * fq;
#pragma unroll
        for (int bj = 0; bj < 2; ++bj)
#pragma unroll
          for (int n = 0; n < 2; ++n) {
            const f32x4 a = acc[ai][bj][m][n] * scale;
            *(uint2*)(rowp + bj * 128 + n * 16) = uint2{cvtpk(a[0], a[1]), cvtpk(a[2], a[3])};
          }
      }
  }
};

struct EpiFourierPart {
  static constexpr bool PERM = false, AFTER_DRAIN = false;
  u16* FP; float scale; int kh;
  DI void operator()(const f32x4 (&acc)[2][2][4][2], const pg8::Unit& u, int wr, int wc, int fr, int fq) const {
    const int mt = u.pm;
    u16* base = FP + ((size_t)(kh * 4 + u.pn) * 2304 + mt * 256 + wr * 64 + fr) * 256 + wc * 32 + 4 * fq;
#pragma unroll
    for (int ai = 0; ai < 2; ++ai)
#pragma unroll
      for (int m = 0; m < 4; ++m) {
        u16* rowp = base + (size_t)(ai * 128 + m * 16) * 256;
#pragma unroll
        for (int bj = 0; bj < 2; ++bj)
#pragma unroll
          for (int n = 0; n < 2; ++n) {
            const f32x4 a = acc[ai][bj][m][n] * scale;
            *(uint2*)(rowp + bj * 128 + n * 16) = uint2{cvtpk(a[0], a[1]), cvtpk(a[2], a[3])};
          }
      }
  }
};
struct OrderF {
  int idx, rem;
  DI bool next(int i, pg8::Unit& u) const {
    if (i != 0 || idx >= 72) return false;
    u.pm = __builtin_amdgcn_readfirstlane(rem % 9);
    u.pn = __builtin_amdgcn_readfirstlane(rem / 9);
    return true;
  }
  DI void a_ready(const pg8::Unit&) const {}
  DI void done(const pg8::Unit&) const {}
};
DI void phase_up(char* smem, const Params& p, int l, int f, int bid, int nb) {
  pg8::Gemm g{(const u16*)(p.ws + OFF_H), (const u16*)(p.ws + OFF_UPT + (size_t)(l * 2 + f) * SZ_UPT), 40960, 5632, 1024, 1024};
  OrderStd S; S.init(160, 22, nb, bid, 0, 0);
  EpiUp E{(u16*)(p.ws + OFF_ACT)};
  pg8::gemm_phase<EpiUp, OrderStd, false>((PG8_LAS unsigned char*)smem, g, S, E, nullptr);
}
DI void phase_resid(char* smem, const Params& p, const u16* A, const u16* Wt, int K, int l, int gate_chunk, float coef, bool from_in, int bid, int nb) {
  pg8::Gemm g{A, Wt, 40960, 1024, K, K};
  OrderStd S; S.init(160, 4, nb, bid, 0, 0);
  EpiResid E{p.x_prompt, p.x_sample, p.out, (const float*)(p.ws + OFF_MOD) + (size_t)l * 9 * 9216 + gate_chunk * 1024, coef, from_in ? 1 : 0};
  pg8::gemm_phase<EpiResid, OrderStd, false>((PG8_LAS unsigned char*)smem, g, S, E, nullptr);
}
DI void phase_proj(char* smem, const Params& p, int l, int r, int bid, int nb) {
  pg8::Gemm g{(const u16*)(p.ws + OFF_H), (const u16*)(p.ws + OFF_INT + (size_t)l * SZ_INT), 40960, 3072, 1024, 1024};
  OrderStd S; S.init(80, 12, nb, bid, 1, r);
  EpiProj E{(u16*)(p.ws + OFF_P), (float*)(p.ws + OFF_GATES), (u16*)(p.ws + OFF_XTC), (u16*)(p.ws + OFF_XTL), r};
  pg8::gemm_phase<EpiProj, OrderStd, false>((PG8_LAS unsigned char*)smem, g, S, E, nullptr);
}

DI void load64(const u16* src, float* v) {
#pragma unroll
  for (int i = 0; i < 8; ++i) unpack8(*(const uint4*)(src + i * 8), v + i * 8);
}
DI void store64(u16* dst, const float* v) {
#pragma unroll
  for (int i = 0; i < 8; ++i)
    *(uint4*)(dst + i * 8) = uint4{pack2bf(v[i * 8], v[i * 8 + 1]), pack2bf(v[i * 8 + 2], v[i * 8 + 3]), pack2bf(v[i * 8 + 4], v[i * 8 + 5]), pack2bf(v[i * 8 + 6], v[i * 8 + 7])};
}
DI void rope64(const float* rope, int pos, float* v) {
  const float* rr = rope + (pos >> 6) * 32;
  const float* rc = rope + (pos & 63) * 32;
#pragma unroll
  for (int i = 0; i < 16; ++i) {
    const float c = rr[i * 2], s = rr[i * 2 + 1];
    const float a = v[i], b = v[16 + i];
    v[i] = a * c - b * s;
    v[16 + i] = b * c + a * s;
    const float c2 = rc[i * 2], s2 = rc[i * 2 + 1];
    const float a2 = v[32 + i], b2 = v[48 + i];
    v[32 + i] = a2 * c2 - b2 * s2;
    v[48 + i] = b2 * c2 + a2 * s2;
  }
}
DI void prep_attn_item(const Params& p, int l, int r, int item) {
  const int tid = opaque_tid(), tk = tid & 63, hh = tid >> 6;
  const int u = item * 64 + tk;
  const bool lat = u >= 4096;
  const u16* prow = (const u16*)(p.ws + OFF_P) + (size_t)u * PW;
  const float* rope = (const float*)(p.ws + OFF_ROPE);
  int bl, pos;
  if (!lat) { bl = u >> 8; pos = u & 255; } else { bl = (u - 4096) >> 12; pos = (u - 4096) & 4095; }
  float v[64];
  {
    load64(prow + hh * 64, v);
    float ss = 0.f;
#pragma unroll
    for (int d = 0; d < 64; ++d) ss += v[d] * v[d];
    const float rstd = rsqrtf(ss * (1.f / 64.f) + 1e-6f);
#pragma unroll
    for (int d = 0; d < 64; ++d) v[d] = v[d] * rstd * p.q_norm[l * 64 + d];
    if (lat) rope64(rope, pos, v);
#pragma unroll
    for (int d = 0; d < 64; ++d) v[d] *= 0.18033688011112042f;
    store64((u16*)(p.ws + OFF_QB) + ((size_t)u * 4 + hh) * 64, v);
  }
  const int kvh = hh & 1;
  if (hh < 2) {
    load64(prow + 256 + kvh * 64, v);
    float ss = 0.f;
#pragma unroll
    for (int d = 0; d < 64; ++d) ss += v[d] * v[d];
    const float rstd = rsqrtf(ss * (1.f / 64.f) + 1e-6f);
#pragma unroll
    for (int d = 0; d < 64; ++d) v[d] = v[d] * rstd * p.k_norm[l * 64 + d];
    if (!lat) {
      const int b = r * 16 + bl;
      float* o = p.out + OUT_K + ((size_t)((b * 2 + l) * 2 + kvh) * 256 + pos) * 64;
#pragma unroll
      for (int d = 0; d < 64; d += 4) *(float4*)(o + d) = float4{v[d], v[d + 1], v[d + 2], v[d + 3]};
      store64((u16*)(p.ws + OFF_KBC) + ((size_t)(bl * 2 + kvh) * 256 + pos) * 64, v);
    } else {
      rope64(rope, pos, v);
      store64((u16*)(p.ws + OFF_KBL) + ((size_t)(bl * 2 + kvh) * 4608 + 512 + pos) * 64, v);
    }
  } else {
    load64(prow + 384 + kvh * 64, v);
    if (!lat) {
      const int b = r * 16 + bl;
      float* o = p.out + OUT_V + ((size_t)((b * 2 + l) * 2 + kvh) * 256 + pos) * 64;
#pragma unroll
      for (int d = 0; d < 64; d += 4) *(float4*)(o + d) = float4{v[d], v[d + 1], v[d + 2], v[d + 3]};
      u16* vt = (u16*)(p.ws + OFF_VTC) + (size_t)(bl * 2 + kvh) * 64 * 256 + pos;
#pragma unroll
      for (int d = 0; d < 64; ++d) vt[(size_t)d * 256] = (u16)f2bf(v[d]);
    } else {
      u16* vt = (u16*)(p.ws + OFF_VTL) + (size_t)(bl * 2 + kvh) * 64 * 4608 + 512 + pos;
#pragma unroll
      for (int d = 0; d < 64; ++d) vt[(size_t)d * 4608] = (u16)f2bf(v[d]);
    }
  }
}
DI void prep_cache_item(const Params& p, int l, int r, int item) {
  const int bl = item >> 4, kvh = (item >> 3) & 1, pblk = item & 7;
  const int tid = opaque_tid(), pp = tid & 63, dq = tid >> 6;
  const int b = r * 4 + bl, pos = pblk * 64 + pp;
  const size_t src = ((size_t)((b * 2 + l) * 2 + kvh) * 512 + pos) * 64 + dq * 16;
  u16* kb = (u16*)(p.ws + OFF_KBL) + ((size_t)(bl * 2 + kvh) * 4608 + pos) * 64 + dq * 16;
  u16* vt = (u16*)(p.ws + OFF_VTL) + ((size_t)(bl * 2 + kvh) * 64 + dq * 16) * 4608 + pos;
  float kv[16], vv[16];
#pragma unroll
  for (int j = 0; j < 4; ++j) {
    const float4 a = *(const float4*)(p.cache_k + src + j * 4);
    const float4 c = *(const float4*)(p.cache_v + src + j * 4);
    kv[j * 4] = a.x; kv[j * 4 + 1] = a.y; kv[j * 4 + 2] = a.z; kv[j * 4 + 3] = a.w;
    vv[j * 4] = c.x; vv[j * 4 + 1] = c.y; vv[j * 4 + 2] = c.z; vv[j * 4 + 3] = c.w;
  }
  *(uint4*)kb = uint4{pack2bf(kv[0], kv[1]), pack2bf(kv[2], kv[3]), pack2bf(kv[4], kv[5]), pack2bf(kv[6], kv[7])};
  *(uint4*)(kb + 8) = uint4{pack2bf(kv[8], kv[9]), pack2bf(kv[10], kv[11]), pack2bf(kv[12], kv[13]), pack2bf(kv[14], kv[15])};
#pragma unroll
  for (int j = 0; j < 16; ++j) vt[(size_t)j * 4608] = (u16)f2bf(vv[j]);
}
DI void prep_convb_item(const Params& p, int l, int r, int item) {
  const int idx = item * 256 + (otid() & 255);
  const int u = idx >> 5, c0 = (idx & 31) * 8;
  const u16* P = (const u16*)(p.ws + OFF_P);
  const int pos = u < 4096 ? (u & 255) : ((u - 4096) & 4095);
  const int L = u < 4096 ? 256 : 4096;
  const float* cw = p.conv_b_w + l * 768;
  float gb[8], gc[8], xb[8], y[8];
  unpack8(*(const uint4*)(P + (size_t)u * PW + 512 + c0), gb);
#pragma unroll
  for (int j = 0; j < 8; ++j) y[j] = 0.f;
#pragma unroll
  for (int dt = 0; dt < 3; ++dt) {
    const int pp = pos + dt - 1;
    if (pp >= 0 && pp < L) {
      const size_t ro = (size_t)(u + dt - 1) * PW;
      unpack8(*(const uint4*)(P + ro + 768 + c0), gc);
      unpack8(*(const uint4*)(P + ro + 1024 + c0), xb);
#pragma unroll
      for (int j = 0; j < 8; ++j) y[j] += gc[j] * xb[j] * cw[dt * 256 + c0 + j];
    }
  }
  u16* M = (u16*)(p.ws + OFF_H) + (size_t)grow_of(u, r) * 1024 + 256 + c0;
  *(uint4*)M = uint4{pack2bf(gb[0] * y[0], gb[1] * y[1]), pack2bf(gb[2] * y[2], gb[3] * y[3]), pack2bf(gb[4] * y[4], gb[5] * y[5]), pack2bf(gb[6] * y[6], gb[7] * y[7])};
}

DI void prep_delta_item(char* smem, const Params& p, int l, int r, int item) {
  const int cpos = item >> 2, h = item & 3;
  const int tid = opaque_tid(), lane = tid & 63, w = tid >> 6, l15 = lane & 15, g = lane >> 4;
  u16* sQ = (u16*)smem;
  u16* sK = sQ + 4608;
  u16* sV = sK + 4608;
  float* sL = (float*)(smem + 27648);
  float* sGc = (float*)(smem + 27648 + 36864);
  float* sBeta = sGc + 128;
  const int u0 = cpos * 64;
  const bool lat = u0 >= 4096;
  const int L = lat ? 4096 : 256;
  const int ul = lat ? u0 - 4096 : u0;
  const int bl = lat ? (ul >> 12) : (ul >> 8);
  const int n = (ul & (L - 1)) >> 6;
  const int NC = L >> 6;
  const u16* P = (const u16*)(p.ws + OFF_P);
  const float* GATES = (const float*)(p.ws + OFF_GATES);
  {
    const int i = tid >> 2, dq = tid & 3;
    const int u = u0 + i;
    const int pos = (ul & (L - 1)) + i;
    const float* cw = p.conv_c_w + l * 3 * 768;
#pragma unroll 1
    for (int which = 0; which < 3; ++which) {
      const int ch = which * 256 + h * 64 + dq * 16;
      float y[16];
#pragma unroll
      for (int j = 0; j < 16; ++j) y[j] = 0.f;
#pragma unroll
      for (int dt = 0; dt < 3; ++dt) {
        const int pp = pos + dt - 1;
        if (pp >= 0 && pp < L) {
          float xin[16];
          const u16* src = P + (size_t)(u + dt - 1) * PW + 1280 + ch;
          unpack8(*(const uint4*)src, xin);
          unpack8(*(const uint4*)(src + 8), xin + 8);
#pragma unroll
          for (int j = 0; j < 16; ++j) y[j] += xin[j] * cw[dt * 768 + ch + j];
        }
      }
      float ss = 0.f;
#pragma unroll
      for (int j = 0; j < 16; ++j) { y[j] = siluf(y[j]); ss += y[j] * y[j]; }
      if (which < 2) {
        ss += sx(ss, 1);
        ss += sx(ss, 2);
        const float sc = rsqrtf(ss + 1e-6f) * (which == 0 ? 0.125f : 1.f);
#pragma unroll
        for (int j = 0; j < 16; ++j) y[j] *= sc;
      }
      u16* dst = (which == 0 ? sQ : which == 1 ? sK : sV) + i * 72 + dq * 16;
      *(uint4*)dst = uint4{pack2bf(y[0], y[1]), pack2bf(y[2], y[3]), pack2bf(y[4], y[5]), pack2bf(y[6], y[7])};
      *(uint4*)(dst + 8) = uint4{pack2bf(y[8], y[9]), pack2bf(y[10], y[11]), pack2bf(y[12], y[13]), pack2bf(y[14], y[15])};
    }
  }
  const int vbsel = (otid() >> 8) & 1;
  if ((w >> 1) == vbsel) {
    const int dir = w & 1;
    const int i = dir ? 63 - lane : lane;
    const float* gr = GATES + (size_t)(u0 + i) * 16;
    const float braw = gr[dir * 4 + h], araw = gr[8 + dir * 4 + h];
    const float beta = 1.f / (1.f + __expf(-braw));
    const float xx = araw + p.delta_dt_bias[(l * 2 + dir) * 4 + h];
    const float sp = fmaxf(xx, 0.f) + log1pf(__expf(-fabsf(xx)));
    float gv = -__expf(p.delta_a_log[(l * 2 + dir) * 4 + h]) * sp;
#pragma unroll
    for (int o = 1; o < 64; o <<= 1) {
      const float t = sup(gv, o);
      if (lane >= o) gv += t;
    }
    sGc[dir * 64 + lane] = gv;
    sBeta[dir * 64 + lane] = beta;
  }
  __syncthreads();
  const int dir = w >> 1, half = w & 1;
  const int cid = lat ? 256 + ((bl * 4 + h) * 64 + (dir ? NC - 1 - n : n)) : ((bl * 4 + h) * 4 + (dir ? NC - 1 - n : n));
  u16* dn = (u16*)(p.ws + OFF_DN + (size_t)(dir * 1280 + cid) * 40960);
  u16* dW = dn, *dQG = dn + 4096, *dAQK = dn + 8192, *dKT = dn + 12288, *dU = dn + 16384;
  const float* gc = sGc + dir * 64;
  {
    float* Ld = sL + dir * 4608;
#pragma unroll
    for (int ii = 0; ii < 2; ++ii) {
      const int it = half * 2 + ii;
      const int arow = dir ? 63 - (it * 16 + l15) : it * 16 + l15;
      bf16x8 ak[2], aq[2];
#pragma unroll
      for (int ks = 0; ks < 2; ++ks) {
        ak[ks] = *(const bf16x8*)(sK + arow * 72 + ks * 32 + g * 8);
        aq[ks] = *(const bf16x8*)(sQ + arow * 72 + ks * 32 + g * 8);
      }
#pragma unroll
      for (int jt = 0; jt < 4; ++jt) {
        const int brow = dir ? 63 - (jt * 16 + l15) : jt * 16 + l15;
        f32x4 kk = f32x4{0.f, 0.f, 0.f, 0.f}, qk = f32x4{0.f, 0.f, 0.f, 0.f};
#pragma unroll
        for (int ks = 0; ks < 2; ++ks) {
          const bf16x8 bk = *(const bf16x8*)(sK + brow * 72 + ks * 32 + g * 8);
          kk = MFMA16(ak[ks], bk, kk);
          qk = MFMA16(aq[ks], bk, qk);
        }
        const int jp = jt * 16 + l15;
        const float gj = gc[jp];
#pragma unroll
        for (int rr = 0; rr < 4; ++rr) {
          const int ip = it * 16 + g * 4 + rr;
          const float dec = __expf(fminf(gc[ip] - gj, 0.f));
          Ld[ip * 72 + jp] = (ip > jp) ? sBeta[dir * 64 + ip] * kk[rr] * dec : 0.f;
          dAQK[ip * 64 + jp] = (u16)f2bf((ip >= jp) ? qk[rr] * dec : 0.f);
        }
      }
    }
  }
  {
    const int hd = tid & 127;
    const int ip = hd & 63, dh = hd >> 6;
    const int srow = dir ? 63 - ip : ip;
    const float eg = __expf(gc[ip]);
    const float ef = __expf(gc[63] - gc[ip]);
#pragma unroll
    for (int d8 = 0; d8 < 4; ++d8) {
      float qv[8];
      unpack8(*(const uint4*)(sQ + srow * 72 + dh * 32 + d8 * 8), qv);
      *(uint4*)(dQG + ip * 64 + dh * 32 + d8 * 8) = uint4{pack2bf(qv[0] * eg, qv[1] * eg), pack2bf(qv[2] * eg, qv[3] * eg), pack2bf(qv[4] * eg, qv[5] * eg), pack2bf(qv[6] * eg, qv[7] * eg)};
      float kv[8];
      unpack8(*(const uint4*)(sK + srow * 72 + dh * 32 + d8 * 8), kv);
#pragma unroll
      for (int j = 0; j < 8; ++j) dKT[(dh * 32 + d8 * 8 + j) * 64 + ip] = (u16)f2bf(kv[j] * ef);
    }
    if (hd == 0) ((float*)(p.ws + OFF_GL))[dir * 1280 + cid] = __expf(gc[63]);
  }
  __syncthreads();
  if (half == vbsel) {
    const float* Ld = sL + dir * 4608;
    float T[64];
#pragma unroll
    for (int i = 0; i < 64; ++i) {
      float t = (i == lane) ? 1.f : 0.f, t2 = 0.f;
#pragma unroll
      for (int j4 = 0; j4 < (i + 3) / 4; ++j4) {
        const float4 lv = *(const float4*)(Ld + i * 72 + j4 * 4);
        if (j4 * 4 + 0 < i) t -= lv.x * T[j4 * 4 + 0];
        if (j4 * 4 + 1 < i) t2 -= lv.y * T[j4 * 4 + 1];
        if (j4 * 4 + 2 < i) t -= lv.z * T[j4 * 4 + 2];
        if (j4 * 4 + 3 < i) t2 -= lv.w * T[j4 * 4 + 3];
      }
      T[i] = t + t2;
      if ((i & 3) == 3) __builtin_amdgcn_sched_barrier(0);
    }
    const float bc = sBeta[dir * 64 + lane];
    const float bg = bc * __expf(gc[lane]);
    u16* Tb = (u16*)(sL + dir * 4608);
    u16* Tbg = Tb + 4608;
#pragma unroll
    for (int i = 0; i < 64; ++i) {
      Tb[i * 72 + lane] = (u16)f2bf(T[i] * bc);
      Tbg[i * 72 + lane] = (u16)f2bf(T[i] * bg);
    }
  }
  __syncthreads();
  {
    const u16* Tb = (const u16*)(sL + dir * 4608);
    const u16* Tbg = Tb + 4608;
#pragma unroll
    for (int ii = 0; ii < 2; ++ii) {
      const int pt = half * 2 + ii;
      bf16x8 ab[2], abg[2];
#pragma unroll
      for (int ks = 0; ks < 2; ++ks) {
        ab[ks] = *(const bf16x8*)(Tb + (pt * 16 + l15) * 72 + ks * 32 + g * 8);
        abg[ks] = *(const bf16x8*)(Tbg + (pt * 16 + l15) * 72 + ks * 32 + g * 8);
      }
#pragma unroll
      for (int dt = 0; dt < 4; ++dt) {
        f32x4 uu = f32x4{0.f, 0.f, 0.f, 0.f}, ww = f32x4{0.f, 0.f, 0.f, 0.f};
#pragma unroll
        for (int ks = 0; ks < 2; ++ks) {
          bf16x8 bv, bk;
#pragma unroll
          for (int j = 0; j < 8; ++j) {
            const int jp = ks * 32 + g * 8 + j;
            const int srow = dir ? 63 - jp : jp;
            bv[j] = (short)sV[srow * 72 + dt * 16 + l15];
            bk[j] = (short)sK[srow * 72 + dt * 16 + l15];
          }
          uu = MFMA16(ab[ks], bv, uu);
          ww = MFMA16(abg[ks], bk, ww);
        }
#pragma unroll
        for (int rr = 0; rr < 4; ++rr) {
          const int ip = pt * 16 + g * 4 + rr;
          dU[ip * 64 + dt * 16 + l15] = (u16)f2bf(uu[rr]);
          dW[ip * 64 + dt * 16 + l15] = (u16)f2bf(ww[rr]);
        }
      }
    }
  }
  __syncthreads();
}

DI void fft1_item(char* smem, const Params& p, int r, int item) {
  const int bl = item >> 8, g4 = (item >> 6) & 3, l2 = item & 63;
  const int tid = opaque_tid(), lane = tid & 63, w = tid >> 6, l15 = lane & 15, g = lane >> 4;
  u16* sXc = (u16*)smem; u16* sXs = sXc + 4608; u16* sC = sXs + 4608; u16* sS = sC + 4608;
  const u16* P = (const u16*)(p.ws + OFF_P);
  const u16* CS = (const u16*)(p.ws + OFF_FFT);
  const float* TW = (const float*)(p.ws + OFF_FFT + 16384);
  {
    const int row = tid >> 2, q = tid & 3;
    const u16* src = P + (size_t)(4096 + bl * 4096 + row * 64 + l2) * PW + 2304 + g4 * 64 + q * 16;
    *(uint4*)(sXc + row * 72 + q * 16) = *(const uint4*)src;
    *(uint4*)(sXc + row * 72 + q * 16 + 8) = *(const uint4*)(src + 8);
    *(uint4*)(sXs + row * 72 + q * 16) = *(const uint4*)(src + 256);
    *(uint4*)(sXs + row * 72 + q * 16 + 8) = *(const uint4*)(src + 264);
    *(uint4*)(sC + row * 72 + q * 16) = *(const uint4*)(CS + row * 64 + q * 16);
    *(uint4*)(sC + row * 72 + q * 16 + 8) = *(const uint4*)(CS + row * 64 + q * 16 + 8);
    *(uint4*)(sS + row * 72 + q * 16) = *(const uint4*)(CS + 4096 + row * 64 + q * 16);
    *(uint4*)(sS + row * 72 + q * 16 + 8) = *(const uint4*)(CS + 4096 + row * 64 + q * 16 + 8);
  }
  __syncthreads();
  bf16x8 aC[2], aS[2], aCn[2], aSn[2];
#pragma unroll
  for (int ks = 0; ks < 2; ++ks) {
    aC[ks] = *(const bf16x8*)(sC + (w * 16 + l15) * 72 + ks * 32 + g * 8);
    aS[ks] = *(const bf16x8*)(sS + (w * 16 + l15) * 72 + ks * 32 + g * 8);
#pragma unroll
    for (int j = 0; j < 8; ++j) { aCn[ks][j] = (short)(aC[ks][j] ^ (short)0x8000); aSn[ks][j] = (short)(aS[ks][j] ^ (short)0x8000); }
  }
  u16* Z1 = (u16*)(p.ws + OFF_XTL);
#pragma unroll
  for (int kt = 0; kt < 4; ++kt) {
    f32x4 accR = f32x4{0.f, 0.f, 0.f, 0.f}, accI = f32x4{0.f, 0.f, 0.f, 0.f};
#pragma unroll
    for (int ks = 0; ks < 2; ++ks) {
      bf16x8 bc, bs;
#pragma unroll
      for (int j = 0; j < 8; ++j) {
        bc[j] = (short)sXc[(ks * 32 + g * 8 + j) * 72 + kt * 16 + l15];
        bs[j] = (short)sXs[(ks * 32 + g * 8 + j) * 72 + kt * 16 + l15];
      }
      accR = MFMA16(aC[ks], bc, accR);
      accR = MFMA16(aSn[ks], bs, accR);
      accI = MFMA16(aCn[ks], bs, accI);
      accI = MFMA16(aSn[ks], bc, accI);
    }
#pragma unroll
    for (int rr = 0; rr < 4; ++rr) {
      const int k1 = w * 16 + g * 4 + rr;
      const float c = TW[(k1 * 64 + l2) * 2], s = TW[(k1 * 64 + l2) * 2 + 1];
      const float zr = accR[rr] * c + accI[rr] * s;
      const float zi = accI[rr] * c - accR[rr] * s;
      const size_t base = ((size_t)(((bl * 4 + g4) * 64 + k1) * 64 + l2) * 2) * 64 + kt * 16 + l15;
      Z1[base] = (u16)f2bf(zr);
      Z1[base + 64] = (u16)f2bf(zi);
    }
  }
  __syncthreads();
}
DI void fft2_item(char* smem, const Params& p, int r, int item) {
  const int bl = item >> 8, g4 = (item >> 6) & 3, k1 = item & 63;
  const int tid = opaque_tid(), lane = tid & 63, w = tid >> 6, l15 = lane & 15, g = lane >> 4;
  u16* sZr = (u16*)smem; u16* sZi = sZr + 4608; u16* sC = sZi + 4608; u16* sS = sC + 4608;
  const u16* CS = (const u16*)(p.ws + OFF_FFT);
  const u16* Z1 = (const u16*)(p.ws + OFF_XTL) + (size_t)(((bl * 4 + g4) * 64 + k1) * 64) * 128;
  {
    const int row = tid >> 2, q = tid & 3;
    const u16* src = Z1 + row * 128 + q * 16;
    *(uint4*)(sZr + row * 72 + q * 16) = *(const uint4*)src;
    *(uint4*)(sZr + row * 72 + q * 16 + 8) = *(const uint4*)(src + 8);
    *(uint4*)(sZi + row * 72 + q * 16) = *(const uint4*)(src + 64);
    *(uint4*)(sZi + row * 72 + q * 16 + 8) = *(const uint4*)(src + 72);
    *(uint4*)(sC + row * 72 + q * 16) = *(const uint4*)(CS + row * 64 + q * 16);
    *(uint4*)(sC + row * 72 + q * 16 + 8) = *(const uint4*)(CS + row * 64 + q * 16 + 8);
    *(uint4*)(sS + row * 72 + q * 16) = *(const uint4*)(CS + 4096 + row * 64 + q * 16);
    *(uint4*)(sS + row * 72 + q * 16 + 8) = *(const uint4*)(CS + 4096 + row * 64 + q * 16 + 8);
  }
  __syncthreads();
  bf16x8 aC[2], aS[2];
#pragma unroll
  for (int ks = 0; ks < 2; ++ks) {
    aC[ks] = *(const bf16x8*)(sC + (w * 16 + l15) * 72 + ks * 32 + g * 8);
    aS[ks] = *(const bf16x8*)(sS + (w * 16 + l15) * 72 + ks * 32 + g * 8);
  }
  u16* M = (u16*)(p.ws + OFF_H);
#pragma unroll
  for (int kt = 0; kt < 4; ++kt) {
    f32x4 acc = f32x4{0.f, 0.f, 0.f, 0.f};
#pragma unroll
    for (int ks = 0; ks < 2; ++ks) {
      bf16x8 br, bi;
#pragma unroll
      for (int j = 0; j < 8; ++j) {
        br[j] = (short)sZr[(ks * 32 + g * 8 + j) * 72 + kt * 16 + l15];
        bi[j] = (short)sZi[(ks * 32 + g * 8 + j) * 72 + kt * 16 + l15];
      }
      acc = MFMA16(aC[ks], br, acc);
      acc = MFMA16(aS[ks], bi, acc);
    }
#pragma unroll
    for (int rr = 0; rr < 4; ++rr) {
      const int k2 = w * 16 + g * 4 + rr;
      const int u = 4096 + bl * 4096 + k1 + 64 * k2;
      M[(size_t)grow_of(u, r) * 1024 + 768 + g4 * 64 + kt * 16 + l15] = (u16)f2bf(acc[rr] * (1.f / 512.f));
    }
  }
  __syncthreads();
}

DI void phase_prep(char* smem0, const Params& p, int l, int r, int bid0, int nb0) {
  const int vb = otid() >> 8;
  char* smem = smem0 + vb * VSM;
  int* ctr = (int*)(p.ws + OFF_CTR) + 16 + l * 2 + r;
  volatile int* slot = (volatile int*)(smem0 + 2 * VSM);
  for (;;) {
    __syncthreads();
    if (otid() == 0) *slot = atomicAdd(ctr, 1);
    __syncthreads();
    const int pair = *slot;
    if (pair >= 2624) break;
    const int it = pair * 2 + vb;
    if (it < 1280) prep_delta_item(smem, p, l, r, it);
    else if (it < 1600) prep_attn_item(p, l, r, it - 1280);
    else if (it < 1664) prep_cache_item(p, l, r, it - 1600);
    else if (it < 4224) prep_convb_item(p, l, r, it - 1664);
    else fft1_item(smem, p, r, it - 4224);
  }
}

DI void scan_item(char* smem, const Params& p, int l, int r, int dir, bool lat, int chain) {
  const int bl = chain >> 2, h = chain & 3;
  const int NC = lat ? 64 : 4;
  const int tid = opaque_tid(), lane = tid & 63, w = tid >> 6, l15 = lane & 15, g = lane >> 4;
  u16* sW = (u16*)smem;
  u16* sQG = sW + 4608, *sAQK = sW + 9216, *sKT = sW + 13824, *sU = sW + 18432;
  const int cid0 = lat ? 256 + chain * 64 : chain * 4;
  const char* dnbase = p.ws + OFF_DN + (size_t)(dir * 1280 + cid0) * 40960;
  const float* GL = (const float*)(p.ws + OFF_GL) + dir * 1280 + cid0;
  u16* O = (u16*)(p.ws + OFF_ODIR) + (size_t)dir * TR * 256;
  const int useq = lat ? 4096 + bl * 4096 : bl * 256;
  const int dv = w * 16 + l15;
  f32x4 S[4];
  if (lat) {
    const int b = r * 4 + bl;
    const float* s0 = p.state_delta + (size_t)(((b * 2 + l) * 2 + dir) * 4 + h) * 4096;
#pragma unroll
    for (int t = 0; t < 4; ++t)
#pragma unroll
      for (int rr = 0; rr < 4; ++rr) S[t][rr] = s0[(t * 16 + g * 4 + rr) * 64 + dv];
  } else {
#pragma unroll
    for (int t = 0; t < 4; ++t) S[t] = f32x4{0.f, 0.f, 0.f, 0.f};
  }
#define REP10(X) X(0) X(1) X(2) X(3) X(4) X(5) X(6) X(7) X(8) X(9)
#define PRE_DECL(i) uint4 pre##i = *(const uint4*)(dnbase + (size_t)(tid + i * 256) * 16);
  REP10(PRE_DECL)
  float gl = GL[0];
  for (int n = 0; n < NC; ++n) {
    __syncthreads();
#define PRE_ST(i) { const int c = tid + i * 256; const int mat = c >> 9, row = (c >> 3) & 63, kc = c & 7; *(uint4*)(sW + mat * 4608 + row * 72 + kc * 8) = pre##i; }
    REP10(PRE_ST)
    const float glc = gl;
    __syncthreads();
    if (n + 1 < NC) {
      const char* nb_ = dnbase + (size_t)(n + 1) * 40960;
#define PRE_LD(i) pre##i = *(const uint4*)(nb_ + (size_t)(tid + i * 256) * 16);
      REP10(PRE_LD)
      gl = GL[n + 1];
    }
    bf16x8 Sb[2], Sn[2];
#pragma unroll
    for (int ks = 0; ks < 2; ++ks) {
      Sb[ks] = pack8(S[2 * ks], S[2 * ks + 1]);
#pragma unroll
      for (int j = 0; j < 8; ++j) Sn[ks][j] = (short)(Sb[ks][j] ^ (short)0x8000);
    }
    f32x4 vn[4];
#pragma unroll
    for (int pt = 0; pt < 4; ++pt) {
#pragma unroll
      for (int rr = 0; rr < 4; ++rr) vn[pt][rr] = bf2f(sU[(pt * 16 + g * 4 + rr) * 72 + dv]);
#pragma unroll
      for (int ks = 0; ks < 2; ++ks) vn[pt] = MFMA16(frag_perm(sW, pt * 16 + l15, ks, g), Sn[ks], vn[pt]);
      __builtin_amdgcn_sched_barrier(0);
    }
    __builtin_amdgcn_sched_barrier(0);
    bf16x8 Vb[2];
#pragma unroll
    for (int ks = 0; ks < 2; ++ks) Vb[ks] = pack8(vn[2 * ks], vn[2 * ks + 1]);
    const int norig = dir ? NC - 1 - n : n;
#pragma unroll
    for (int pt = 0; pt < 4; ++pt) {
      f32x4 o = f32x4{0.f, 0.f, 0.f, 0.f};
#pragma unroll
      for (int ks = 0; ks < 2; ++ks) {
        o = MFMA16(frag_perm(sQG, pt * 16 + l15, ks, g), Sb[ks], o);
        o = MFMA16(frag_perm(sAQK, pt * 16 + l15, ks, g), Vb[ks], o);
      }
#pragma unroll
      for (int rr = 0; rr < 4; ++rr) {
        const int ip = pt * 16 + g * 4 + rr;
        const int i = dir ? 63 - ip : ip;
        O[(size_t)(useq + norig * 64 + i) * 256 + h * 64 + dv] = (u16)f2bf(o[rr]);
      }
      __builtin_amdgcn_sched_barrier(0);
    }
#pragma unroll
    for (int t = 0; t < 4; ++t) {
      S[t] = S[t] * glc;
#pragma unroll
      for (int ks = 0; ks < 2; ++ks) S[t] = MFMA16(frag_perm(sKT, t * 16 + l15, ks, g), Vb[ks], S[t]);
    }
  }
  if (!lat) {
    const int b = r * 16 + bl;
    float* so = p.out + OUT_S + (size_t)(((b * 2 + l) * 2 + dir) * 4 + h) * 4096;
#pragma unroll
    for (int t = 0; t < 4; ++t)
#pragma unroll
      for (int rr = 0; rr < 4; ++rr) so[(t * 16 + g * 4 + rr) * 64 + dv] = S[t][rr];
  }
  __syncthreads();
}

template <int QT>
DI void attn_item(char* smem, const Params& p, int r, bool lat, int bl, int hq, int q0) {
  const int kvh = hq >> 1;
  const int Lk = lat ? 4608 : 256;
  const int useq = lat ? 4096 + bl * 4096 : bl * 256;
  const u16* Kb = lat ? (const u16*)(p.ws + OFF_KBL) + (size_t)(bl * 2 + kvh) * 4608 * 64 : (const u16*)(p.ws + OFF_KBC) + (size_t)(bl * 2 + kvh) * 256 * 64;
  const u16* Vt = lat ? (const u16*)(p.ws + OFF_VTL) + (size_t)(bl * 2 + kvh) * 64 * 4608 : (const u16*)(p.ws + OFF_VTC) + (size_t)(bl * 2 + kvh) * 64 * 256;
  const u16* Qb = (const u16*)(p.ws + OFF_QB);
  const int tid = opaque_tid(), lane = tid & 63, w = tid >> 6, l15 = lane & 15, g = lane >> 4;
  u16* sK = (u16*)smem;
  u16* sV = (u16*)(smem + 18432);
  const int uq0 = useq + q0 + w * (16 * QT);
  bf16x8 qf[QT][2];
#pragma unroll
  for (int qt = 0; qt < QT; ++qt)
#pragma unroll
    for (int ks = 0; ks < 2; ++ks) qf[qt][ks] = *(const bf16x8*)(Qb + ((size_t)(uq0 + qt * 16 + l15) * 4 + hq) * 64 + ks * 32 + g * 8);
  f32x4 oacc[4][QT];
#pragma unroll
  for (int dt = 0; dt < 4; ++dt)
#pragma unroll
    for (int qt = 0; qt < QT; ++qt) oacc[dt][qt] = f32x4{0.f, 0.f, 0.f, 0.f};
  float mrun[QT], lrun[QT];
#pragma unroll
  for (int qt = 0; qt < QT; ++qt) { mrun[qt] = -1e30f; lrun[qt] = 0.f; }
  const int NT = Lk >> 6;
#define REP4(X) X(0) X(1) X(2) X(3)
  uint4 apre0, apre1, apre2, apre3;
#define AT_LD(i) { const int c = tid + i * 256; const int row = (c >> 3) & 63, kc = c & 7; \
    apre##i = (c < 512) ? *(const uint4*)(Kb + (size_t)(kt_ * 64 + row) * 64 + kc * 8) : *(const uint4*)(Vt + (size_t)row * Lk + kt_ * 64 + kc * 8); }
#define AT_ST(i) { const int c = tid + i * 256; const int row = (c >> 3) & 63, kc = c & 7; \
    *(uint4*)((c < 512 ? sK : sV) + buf_ * 4608 + row * 72 + kc * 8) = apre##i; }
#define gload(kt) { const int kt_ = (kt); REP4(AT_LD) }
#define sstore(b) { const int buf_ = (b); REP4(AT_ST) }
  gload(0)
  sstore(0)
  __syncthreads();
  for (int kt = 0; kt < NT; ++kt) {
    const int buf = kt & 1;
    if (kt + 1 < NT) gload(kt + 1)
    const u16* cK = sK + buf * 4608;
    const u16* cV = sV + buf * 4608;
    f32x4 sacc[4][QT];
#pragma unroll
    for (int k4 = 0; k4 < 4; ++k4) {
      bf16x8 kf[2];
#pragma unroll
      for (int ks = 0; ks < 2; ++ks) kf[ks] = *(const bf16x8*)(cK + (k4 * 16 + l15) * 72 + ks * 32 + g * 8);
#pragma unroll
      for (int qt = 0; qt < QT; ++qt) {
        f32x4 a = f32x4{0.f, 0.f, 0.f, 0.f};
        a = MFMA16(kf[0], qf[qt][0], a);
        a = MFMA16(kf[1], qf[qt][1], a);
        sacc[k4][qt] = a;
      }
    }
    bf16x8 pb[QT][2];
    float mxl[QT];
#pragma unroll
    for (int qt = 0; qt < QT; ++qt) {
      float mx = sacc[0][qt][0];
#pragma unroll
      for (int k4 = 0; k4 < 4; ++k4)
#pragma unroll
        for (int rr = 0; rr < 4; ++rr) mx = fmaxf(mx, sacc[k4][qt][rr]);
      mxl[qt] = mx;
    }
    bool need = false;
#pragma unroll
    for (int qt = 0; qt < QT; ++qt) need = need || (mxl[qt] > mrun[qt] + 8.f);
    if (__builtin_amdgcn_ballot_w64(need) != 0ull) {
#pragma unroll
      for (int qt = 0; qt < QT; ++qt) {
        float mx = mxl[qt];
        mx = fmaxf(mx, sx(mx, 16));
        mx = fmaxf(mx, sx(mx, 32));
        const float mnew = fmaxf(mrun[qt], mx);
        const float alpha = __builtin_amdgcn_exp2f(mrun[qt] - mnew);
        mrun[qt] = mnew;
        lrun[qt] *= alpha;
#pragma unroll
        for (int dt = 0; dt < 4; ++dt) oacc[dt][qt] = oacc[dt][qt] * alpha;
      }
    }
#pragma unroll
    for (int qt = 0; qt < QT; ++qt) {
      const float mref = mrun[qt];
      float ps = 0.f;
#pragma unroll
      for (int k4 = 0; k4 < 4; ++k4)
#pragma unroll
        for (int rr = 0; rr < 4; ++rr) {
          const float e = __builtin_amdgcn_exp2f(sacc[k4][qt][rr] - mref);
          sacc[k4][qt][rr] = e;
          ps += e;
        }
      lrun[qt] += ps;
      pb[qt][0] = pack8(sacc[0][qt], sacc[1][qt]);
      pb[qt][1] = pack8(sacc[2][qt], sacc[3][qt]);
    }
#pragma unroll
    for (int dt = 0; dt < 4; ++dt)
#pragma unroll
      for (int ks = 0; ks < 2; ++ks) {
        const bf16x8 vf = frag_perm(cV, dt * 16 + l15, ks, g);
#pragma unroll
        for (int qt = 0; qt < QT; ++qt) oacc[dt][qt] = MFMA16(vf, pb[qt][ks], oacc[dt][qt]);
      }
    if (kt + 1 < NT) sstore(buf ^ 1)
    __syncthreads();
  }
  u16* M = (u16*)(p.ws + OFF_H);
#pragma unroll
  for (int qt = 0; qt < QT; ++qt) {
    float lt = lrun[qt];
    lt += sx(lt, 16);
    lt += sx(lt, 32);
    const float inv = 1.f / lt;
    const int u = uq0 + qt * 16 + l15;
    u16* dst = M + (size_t)grow_of(u, r) * 1024 + hq * 64 + g * 4;
#pragma unroll
    for (int dt = 0; dt < 4; ++dt) {
      const f32x4 o = oacc[dt][qt];
      *(uint2*)(dst + dt * 16) = uint2{pack2bf(o[0] * inv, o[1] * inv), pack2bf(o[2] * inv, o[3] * inv)};
    }
  }
}

DI void phase_mix(char* smem0, const Params& p, int l, int ra, int bid0, int nb0) {
  const int r = ra & 1;
  {
    pg8::Gemm g{(const u16*)(p.ws + OFF_DFTC), (const u16*)(p.ws + OFF_XTC), 256, 4096, 512, 512};
    OrderOne S{bid0, 16, 1};
    EpiFourier E{(u16*)(p.ws + OFF_H), r, 0, 1.f / 128.f};
    pg8::gemm_phase<EpiFourier, OrderOne, false>((PG8_LAS unsigned char*)smem0, g, S, E, nullptr);
  }
  const int vb = otid() >> 8;
  char* smem = smem0 + vb * VSM;
  int* ctr = (int*)(p.ws + OFF_CTR) + l * 2 + r + 4 * (ra >> 1);
  volatile int* slot = (volatile int*)(smem0 + 2 * VSM);
  for (;;) {
    __syncthreads();
    if (otid() == 0) *slot = atomicAdd(ctr, 1);
    __syncthreads();
    const int pair = *slot;
    if (pair >= 928) break;
    const int it = pair * 2 + vb;
    if (it < 32) scan_item(smem, p, l, r, it >> 4, true, it & 15);
    else if (it < 512) { const int j = it - 32; attn_item<2>(smem, p, r, true, j / 120, (j / 30) & 3, (j % 30) * 128); }
    else if (it < 576) { const int j = it - 512; attn_item<1>(smem, p, r, true, j >> 4, (j >> 2) & 3, 3840 + (j & 3) * 64); }
    else if (it < 1600) fft2_item(smem, p, r, it - 576);
    else if (it < 1728) { const int j = it - 1600; scan_item(smem, p, l, r, j >> 6, false, j & 63); }
    else { const int j = it - 1728; attn_item<2>(smem, p, r, false, j >> 3, (j >> 1) & 3, (j & 1) * 128); }
  }
}

DI void phase_post(const Params& p, int l, int r, int bid, int nb) {
  const u16* O0 = (const u16*)(p.ws + OFF_ODIR);
  const u16* O1 = O0 + (size_t)TR * 256;
  const u16* P = (const u16*)(p.ws + OFF_P);
  u16* M = (u16*)(p.ws + OFF_H);
  for (int it = bid * 2 + (otid() >> 8); it < TR * 16 / 256; it += nb * 2) {
    const int idx = it * 256 + (otid() & 255);
    const int u = idx >> 4, h = (idx >> 2) & 3, q4 = idx & 3;
    const int c0 = h * 64 + q4 * 16;
    float a[16], b[16], z[16];
    unpack8(*(const uint4*)(O0 + (size_t)u * 256 + c0), a);
    unpack8(*(const uint4*)(O0 + (size_t)u * 256 + c0 + 8), a + 8);
    unpack8(*(const uint4*)(O1 + (size_t)u * 256 + c0), b);
    unpack8(*(const uint4*)(O1 + (size_t)u * 256 + c0 + 8), b + 8);
    unpack8(*(const uint4*)(P + (size_t)u * PW + 2048 + c0), z);
    unpack8(*(const uint4*)(P + (size_t)u * PW + 2048 + c0 + 8), z + 8);
    float ss = 0.f;
#pragma unroll
    for (int j = 0; j < 16; ++j) { a[j] += b[j]; ss += a[j] * a[j]; }
    ss += sx(ss, 1);
    ss += sx(ss, 2);
    const float rstd = rsqrtf(ss * (1.f / 64.f) + 1e-6f);
    float o[16];
#pragma unroll
    for (int j = 0; j < 16; ++j) o[j] = a[j] * rstd * p.delta_norm[l * 64 + q4 * 16 + j] * siluf(z[j]);
    u16* dst = M + (size_t)grow_of(u, r) * 1024 + 512 + c0;
    *(uint4*)dst = uint4{pack2bf(o[0], o[1]), pack2bf(o[2], o[3]), pack2bf(o[4], o[5]), pack2bf(o[6], o[7])};
    *(uint4*)(dst + 8) = uint4{pack2bf(o[8], o[9]), pack2bf(o[10], o[11]), pack2bf(o[12], o[13]), pack2bf(o[14], o[15])};
  }
}

#define XB_TMO      128
#define XB_XCNT(j)  (256  + 64 * (j))
#define XB_XSUB(j)  (1280 + 64 * (j))
#define XB_XGEN(j)  (2304 + 64 * (j))
#define XB_TOP      3328
#define XB_TOPGEN   3392
#define XCD_BAR_WORDS 3456
#define XB_SPIN_CAP (1u << 22)
#define LAS __attribute__((address_space(3)))

__device__ __forceinline__ unsigned xb_ld(unsigned* p)              { return __hip_atomic_load(p, __ATOMIC_RELAXED, __HIP_MEMORY_SCOPE_AGENT); }
__device__ __forceinline__ unsigned xb_add(unsigned* p, unsigned v) { return __hip_atomic_fetch_add(p, v, __ATOMIC_RELAXED, __HIP_MEMORY_SCOPE_AGENT); }
__device__ __forceinline__ unsigned xb_xcc_id() { return (unsigned)__builtin_amdgcn_s_getreg((3 << 11) | 20) & 0xFu; }
#define XB_SPIN(cond, bar) do { unsigned _sp = 0; while (cond) { __builtin_amdgcn_s_sleep(1); \
    if ((++_sp & 255u) == 0u) { if (xb_ld(&(bar)[XB_TMO])) break; if (_sp > XB_SPIN_CAP) { atomicAdd(&(bar)[XB_TMO], 1u); break; } } } } while (0)

struct XcdBarrier {
    unsigned* bar; unsigned x;
    volatile LAS unsigned* st;
};

__device__ __forceinline__ XcdBarrier xcd_barrier_post(unsigned* bar, volatile LAS unsigned* st) {
    XcdBarrier b; b.bar = bar; b.x = xb_xcc_id(); b.st = st;
    if (threadIdx.x == 0) (void)xb_add(&bar[XB_XCNT(b.x)], 1u);
    return b;
}
__device__ __forceinline__ void xcd_barrier_complete(unsigned* bar, unsigned x, unsigned& nloc, unsigned& nx) {
    const unsigned G = gridDim.x * gridDim.y * gridDim.z;
    unsigned sum, cnt, mine, sp = 0u;
    for (;;) {
        sum = 0u; cnt = 0u; mine = 0u;
#pragma unroll
        for (unsigned j = 0; j < 16; ++j) { const unsigned c = xb_ld(&bar[XB_XCNT(j)]); sum += c; cnt += (c > 0u) ? 1u : 0u; mine = (j == x) ? c : mine; }
        if (sum == G) break;
        __builtin_amdgcn_s_sleep(1);
        if ((++sp & 255u) == 0u) { if (xb_ld(&bar[XB_TMO])) break; if (sp > XB_SPIN_CAP) { atomicAdd(&bar[XB_TMO], 1u); break; } }
    }
    nloc = mine > 0u ? mine : 1u; nx = cnt > 0u ? cnt : 1u;
}

__device__ __forceinline__ void xcd_barrier(const XcdBarrier& b) {
    asm volatile("s_waitcnt vmcnt(0)" ::: "memory");
    __syncthreads();
    if (threadIdx.x == 0) {
        unsigned* bar = b.bar;
        __builtin_amdgcn_s_waitcnt(0);
        unsigned nloc = b.st[0], nx = b.st[1];
        if (nloc == 0u) { xcd_barrier_complete(bar, b.x, nloc, nx); b.st[0] = nloc; b.st[1] = nx; }
        const unsigned old = xb_add(&bar[XB_XSUB(b.x)], 1u);
        const unsigned gen = old / nloc;
        if (old + 1u == (gen + 1u) * nloc) {
            __builtin_amdgcn_fence(__ATOMIC_RELEASE, "agent");
            asm volatile("s_waitcnt vmcnt(0)" ::: "memory");
            const unsigned og = xb_add(&bar[XB_TOP], 1u);
            const unsigned tg = og / nx;
            if (og + 1u == (tg + 1u) * nx) xb_add(&bar[XB_TOPGEN], 1u);
            else XB_SPIN(xb_ld(&bar[XB_TOPGEN]) == tg, bar);
            __builtin_amdgcn_fence(__ATOMIC_ACQUIRE, "agent");
            xb_add(&bar[XB_XGEN(b.x)], 1u);
            asm volatile("s_waitcnt vmcnt(0)" ::: "memory");
        } else {
            XB_SPIN(xb_ld(&bar[XB_XGEN(b.x)]) == gen, bar);
            __builtin_amdgcn_fence(__ATOMIC_ACQUIRE, "agent");
            asm volatile("s_waitcnt vmcnt(0)" ::: "memory");
        }
    }
    __syncthreads();
}


DI void run_phase(char* smem, const Params& p0, int ph, int l, int a, int bid, int nb) {
  Params p = p0;
  { char* w_ = p.ws; asm volatile("" : "+s"(w_)); p.ws = w_; float* o_ = p.out; asm volatile("" : "+s"(o_)); p.out = o_; }
  asm volatile("" : "+s"(bid));
  asm volatile("" : "+s"(nb));
  switch (ph) {
    case 0: phase_init(smem, p, bid, nb); break;
    case 1: phase_norm(p, l, a, bid, nb); break;
    case 2: phase_up(smem, p, l, a, bid, nb); break;
    case 3: phase_resid(smem, p, (const u16*)(p.ws + OFF_ACT), (const u16*)(p.ws + OFF_DNT + (size_t)(l * 2 + a) * SZ_DNT), 2816, l, a ? 8 : 2, 0.5f, l == 0 && a == 0, bid, nb); break;
    case 4: phase_proj(smem, p, l, a, bid, nb); break;
    case 5: phase_prep(smem, p, l, a, bid, nb); break;
    case 6: phase_mix(smem, p, l, a, bid, nb); break;
    case 7: phase_post(p, l, a, bid, nb); break;
    case 8: phase_resid(smem, p, (const u16*)(p.ws + OFF_H), (const u16*)(p.ws + OFF_OUTT + (size_t)l * SZ_OUTT), 1024, l, 5, 1.f, false, bid, nb); break;
    default: phase_final(p, bid, nb); break;
  }
}

struct Step { int ph, l, a; };
__host__ __device__ inline int build_program(Step* s) {
  int n = 0;
  auto add = [&](int ph, int l, int a) { if (s) { s[n].ph = ph; s[n].l = l; s[n].a = a; } ++n; };
  add(0, 0, 0);
  for (int l = 0; l < 2; ++l) {
    add(1, l, 0); add(2, l, 0); add(3, l, 0);
    add(1, l, 1);
    for (int r = 0; r < 2; ++r) { add(4, l, r); add(5, l, r); add(6, l, r); add(7, l, r); }
    add(8, l, 0);
    add(1, l, 2); add(2, l, 1); add(3, l, 1);
  }
  add(9, 0, 0);
  return n;
}

template <int PH>
__global__ void __launch_bounds__(512, 2) k_phase(Params p, int l, int a) {
  extern __shared__ __attribute__((aligned(16))) char smem[];
  if (a == 0) run_phase(smem, p, PH, l, 0, blockIdx.x, gridDim.x);
  else if (a == 1) run_phase(smem, p, PH, l, 1, blockIdx.x, gridDim.x);
  else run_phase(smem, p, PH, l, 2, blockIdx.x, gridDim.x);
}
typedef void (*phase_fn)(Params, int, int);
static phase_fn phase_table[10] = {k_phase<0>, k_phase<1>, k_phase<2>, k_phase<3>, k_phase<4>, k_phase<5>, k_phase<6>, k_phase<7>, k_phase<8>, k_phase<9>};

__global__ void __launch_bounds__(512, 2) k_mega(Params p) {
  extern __shared__ __attribute__((aligned(16))) char smem[];
  cg::grid_group grid = cg::this_grid();
  const int bid = blockIdx.x, nb = gridDim.x;
  volatile LAS unsigned* st = (volatile LAS unsigned*)(smem + 2 * VSM + 16);
  if (threadIdx.x == 0) { st[0] = 0u; st[1] = 0u; }
  run_phase(smem, p, 0, 0, 0, bid, nb);
  grid.sync();
  const XcdBarrier xb = xcd_barrier_post((unsigned*)(p.ws + OFF_BAR), st);
#define GSYNC() xcd_barrier(xb)
  for (int l = 0; l < 2; ++l) {
    run_phase(smem, p, 1, l, 0, bid, nb); GSYNC();
    run_phase(smem, p, 2, l, 0, bid, nb); GSYNC();
    run_phase(smem, p, 3, l, 0, bid, nb); GSYNC();
    run_phase(smem, p, 1, l, 1, bid, nb); GSYNC();
    for (int r = 0; r < 2; ++r) {
      run_phase(smem, p, 4, l, r, bid, nb); GSYNC();
      run_phase(smem, p, 5, l, r, bid, nb); GSYNC();
      run_phase(smem, p, 6, l, r, bid, nb); GSYNC();
      run_phase(smem, p, 7, l, r, bid, nb); GSYNC();
    }
    run_phase(smem, p, 8, l, 0, bid, nb); GSYNC();
    run_phase(smem, p, 1, l, 2, bid, nb); GSYNC();
    run_phase(smem, p, 2, l, 1, bid, nb); GSYNC();
    run_phase(smem, p, 3, l, 1, bid, nb); GSYNC();
  }
  run_phase(smem, p, 9, 0, 0, bid, nb);
}

extern "C" void kernel_launch(void* const* d_in, const int* in_sizes, int n_in, void* d_out, int out_size, void* d_ws, size_t ws_size, hipStream_t stream) {
  static int grid_blocks = 0;
  if (grid_blocks == 0) {
    if (ws_size < WS_END) { fprintf(stderr, "kernel_launch: workspace too small: %zu < %zu\n", ws_size, (size_t)WS_END); grid_blocks = -1; return; }
    int dev = 0, cus = 0, per_cu = 0;
    hipGetDevice(&dev);
    hipDeviceGetAttribute(&cus, hipDeviceAttributeMultiprocessorCount, dev);
    hipFuncSetAttribute((const void*)k_mega, hipFuncAttributeMaxDynamicSharedMemorySize, LDS_BYTES);
    for (int i = 0; i < 10; ++i) hipFuncSetAttribute((const void*)phase_table[i], hipFuncAttributeMaxDynamicSharedMemorySize, LDS_BYTES);
    hipOccupancyMaxActiveBlocksPerMultiprocessor(&per_cu, (const void*)k_mega, 512, LDS_BYTES);
    if (per_cu < 1) per_cu = 1;
    if (per_cu > 1) per_cu = 1;
    grid_blocks = cus * per_cu;
  }
  if (grid_blocks < 0) return;
  Params p{};
  const float** pf = (const float**)&p;
  for (int i = 0; i < 28; ++i) pf[i] = (const float*)d_in[i];
  p.out = (float*)d_out;
  p.ws = (char*)d_ws;
#if MULTI_LAUNCH
  Step prog[64];
  const int n = build_program(prog);
  for (int i = 0; i < n; ++i) hipLaunchKernelGGL(phase_table[prog[i].ph], dim3(grid_blocks), dim3(512), LDS_BYTES, stream, p, prog[i].l, prog[i].a);
#else
  void* args[] = {&p};
  hipError_t e = hipLaunchCooperativeKernel((const void*)k_mega, dim3(grid_blocks), dim3(512), args, LDS_BYTES, stream);
  if (e != hipSuccess) fprintf(stderr, "cooperative launch failed: %s (grid %d)\n", hipGetErrorString(e), grid_blocks);
#endif
}
```

```cpp
#include <hip/hip_runtime.h>
#include <hip/hip_cooperative_groups.h>
#include <stdint.h>
#include <stdio.h>
namespace cg = cooperative_groups;

#ifndef MULTI_LAUNCH
#define MULTI_LAUNCH 0
#endif

typedef unsigned short u16;
using bf16x8 = __attribute__((ext_vector_type(8))) short;
using s16x4 = __attribute__((ext_vector_type(4))) short;
using f32x4 = __attribute__((ext_vector_type(4))) float;
#define DI __device__ __forceinline__
#define MFMA16(a, b, c) __builtin_amdgcn_mfma_f32_16x16x32_bf16((a), (b), (c), 0, 0, 0)

constexpr int VSM = 73728;
constexpr int LDS_BYTES = 2 * VSM + 64;
constexpr int TR = 20480;
constexpr int PW = 2816;

constexpr size_t SZ_UPT = 5632ull * 1024 * 2;
constexpr size_t SZ_DNT = 1024ull * 2816 * 2;
constexpr size_t SZ_INT = 3072ull * 1024 * 2;
constexpr size_t SZ_OUTT = 1024ull * 1024 * 2;
constexpr size_t OFF_UPT = 0;
constexpr size_t OFF_DNT = OFF_UPT + 4 * SZ_UPT;
constexpr size_t OFF_INT = OFF_DNT + 4 * SZ_DNT;
constexpr size_t OFF_OUTT = OFF_INT + 2 * SZ_INT;
constexpr size_t OFF_MOD = OFF_OUTT + 2 * SZ_OUTT;
constexpr size_t OFF_ROPE = OFF_MOD + 663552;
constexpr size_t OFF_FFT = OFF_ROPE + 8192;
constexpr size_t OFF_DFTC = OFF_FFT + 65536;
constexpr size_t OFF_H = OFF_DFTC + 262144;
constexpr size_t OFF_X = OFF_H + 83886080;
constexpr size_t OFF_ACT = OFF_X;
constexpr size_t OFF_P = OFF_X;
constexpr size_t OFF_GATES = OFF_P + 115343360;
constexpr size_t OFF_XTC = OFF_GATES + 1310720;
constexpr size_t OFF_XTL = OFF_XTC + 4194304;
constexpr size_t OFF_QB = OFF_XTL + 16777216;
constexpr size_t OFF_KBC = OFF_QB + 10485760;
constexpr size_t OFF_KBL = OFF_KBC + 1048576;
constexpr size_t OFF_VTC = OFF_KBL + 4718592;
constexpr size_t OFF_VTL = OFF_VTC + 1048576;
constexpr size_t OFF_DN = OFF_VTL + 4718592;
constexpr size_t OFF_GL = OFF_DN + 104857600;
constexpr size_t OFF_ODIR = OFF_GL + 10240;
constexpr size_t OFF_CTR = OFF_ODIR + 20971520;
constexpr size_t OFF_BAR = OFF_CTR + 256;
constexpr size_t WS_END = OFF_BAR + 16384;

constexpr size_t OUT_K = 41943040;
constexpr size_t OUT_V = 44040192;
constexpr size_t OUT_S = 46137344;

struct Params {
  const float *x_prompt, *x_sample, *c, *cache_k, *cache_v, *state_delta, *c_ctx, *mod_w, *mod_b, *norm_ffn1, *norm_mix,
      *norm_ffn2, *ffn1_w1, *ffn1_w3, *ffn1_w2, *ffn2_w1, *ffn2_w3, *ffn2_w2, *w_in, *w_out, *q_norm, *k_norm, *conv_b_w,
      *conv_c_w, *delta_a_log, *delta_dt_bias, *delta_norm, *final_norm;
  float* out;
  char* ws;
};

DI int otid() { int t = threadIdx.x; asm volatile("" : "+v"(t)); return t; }
DI float sx(float v, int m) { const int idx = ((otid() & 63) ^ m) << 2; return __int_as_float(__builtin_amdgcn_ds_bpermute(idx, __float_as_int(v))); }
DI float sup(float v, int o) { const int idx = ((otid() & 63) - o) << 2; return __int_as_float(__builtin_amdgcn_ds_bpermute(idx, __float_as_int(v))); }
DI int opaque_tid() { int t = threadIdx.x & 255; asm volatile("" : "+v"(t)); return t; }
typedef float f32x2_t __attribute__((ext_vector_type(2)));
typedef __bf16 bf16x2_t __attribute__((ext_vector_type(2)));
DI unsigned cvtpk(float lo, float hi) { const f32x2_t v = {lo, hi}; const bf16x2_t b = __builtin_convertvector(v, bf16x2_t); return __builtin_bit_cast(unsigned, b); }
DI short f2bf(float x) { return (short)(cvtpk(x, 0.f) & 0xffffu); }
DI float bf2f(u16 b) { return __uint_as_float(((unsigned)b) << 16); }
DI unsigned pack2bf(float a, float b) { return cvtpk(a, b); }
DI float siluf(float x) { return x * __builtin_amdgcn_rcpf(1.f + __builtin_amdgcn_exp2f(-1.4426950408889634f * x)); }
DI bf16x8 pack8(f32x4 lo, f32x4 hi) {
  const uint4 v = uint4{cvtpk(lo[0], lo[1]), cvtpk(lo[2], lo[3]), cvtpk(hi[0], hi[1]), cvtpk(hi[2], hi[3])};
  return __builtin_bit_cast(bf16x8, v);
}
DI bf16x8 frag_perm(const u16* base, int row, int ks, int g) {
  const u16* q = base + row * 72 + ks * 32 + g * 4;
  s16x4 lo = *(const s16x4*)q;
  s16x4 hi = *(const s16x4*)(q + 16);
  return __builtin_shufflevector(lo, hi, 0, 1, 2, 3, 4, 5, 6, 7);
}
DI void unpack8(uint4 v, float* f) {
  f[0] = __uint_as_float(v.x << 16); f[1] = __uint_as_float(v.x & 0xffff0000u);
  f[2] = __uint_as_float(v.y << 16); f[3] = __uint_as_float(v.y & 0xffff0000u);
  f[4] = __uint_as_float(v.z << 16); f[5] = __uint_as_float(v.z & 0xffff0000u);
  f[6] = __uint_as_float(v.w << 16); f[7] = __uint_as_float(v.w & 0xffff0000u);
}
DI int grow_of(int u, int r) { return u < 4096 ? u + 4096 * r : u + 4096 + 16384 * r; }
DI int modv_of(int grow) { return grow < 8192 ? 0 : 1 + ((grow - 8192) >> 12); }

namespace pg8 {
#define PG8_LAS __attribute__((address_space(3)))
typedef unsigned short bf16_t;
typedef short bf16x8 __attribute__((ext_vector_type(8)));
typedef float f32x4 __attribute__((ext_vector_type(4)));
typedef unsigned u32x4 __attribute__((ext_vector_type(4)));
constexpr int BM = 256, BK = 64, HALF = 128, HTB = HALF * BK * 2  , STAGE_BYTES = 8 * HTB, NXCD = 8, WGM = 8;

__host__ __device__ __forceinline__ int lds_byte(int r, int c) { const int st = (r >> 4) * 2 + (c >> 5), rr = r & 15, cc = c & 31, ob = rr * 64 + cc * 2; return st * 1024 + (ob ^ (((ob >> 9) & 1) << 5)); }
__host__ __device__ __forceinline__ void stage_rc(int b, int& R, int& C) { const int st = b / 1024, sb = b % 1024, swz = sb ^ (((sb >> 9) & 1) << 5); R = (st >> 1) * 16 + swz / 64; C = (st & 1) * 32 + (swz % 64) / 2; }
__host__ __device__ __forceinline__ int perm32(int rho) { const int n = rho >> 4, i = rho & 15; return 8 * (i >> 2) + 4 * n + (i & 3); }

struct Unit { int pm, pn; };
struct Gemm { const bf16_t* A; const bf16_t* Bt; int M, N, K, ld; };

__device__ __forceinline__ unsigned cvt_pk_bf16(float lo, float hi) { unsigned r; asm volatile("v_cvt_pk_bf16_f32 %0, %1, %2" : "=v"(r) : "v"(lo), "v"(hi)); return r; }
template <class Epi, class Sched, bool STAMP = false>
__device__ __forceinline__ void gemm_phase(PG8_LAS unsigned char* lds, const Gemm g, const Sched& S, const Epi& E, unsigned long long* stamps) {
    int tid_ = threadIdx.x; asm volatile("" : "+v"(tid_));
    const int tid = tid_, wid = __builtin_amdgcn_readfirstlane(tid >> 6), lane = tid & 63, wr = wid >> 2, wc = wid & 3, fr = lane & 15, fq = lane >> 4;
    const int K = g.ld, nt = g.K / BK;
    int ts_lo = 0, ts_hi = 0, nts = 0; const unsigned long long rt_entry = STAMP ? (unsigned long long)wall_clock64() : 0ull;
#define PG8_STAMP() do { if (STAMP && wid == 0 && nts < 64) { const unsigned long long _c = (unsigned long long)clock64(); \
        ts_lo = (lane == nts) ? (int)(unsigned)_c : ts_lo; ts_hi = (lane == nts) ? (int)(unsigned)(_c >> 32) : ts_hi; ++nts; } } while (0)
    PG8_STAMP();
    unsigned voffA[2], voffB[2];
#pragma unroll
    for (int i = 0; i < 2; ++i) { int R, C; stage_rc(tid * 16 + i * 8192, R, C); const int Rb = Epi::PERM ? ((R & ~31) + perm32(R & 31)) : R;
        voffA[i] = (unsigned)(R * K + C) * 2u; voffB[i] = (unsigned)(Rb * K + C) * 2u; }
    const size_t kstep = (size_t)(BK * 2);
    const size_t hstep = (size_t)HALF * K * 2;
    const size_t tstep = 2 * hstep;
    const unsigned ldsw = (unsigned)wid * 1024u;
    const int aoff = lds_byte(wr * 64 + fr, fq * 8), boff = lds_byte(wc * 32 + fr, fq * 8);
#define PG8_SA(b, h) (((b) * 2 + (h)) * HTB)
#define PG8_SB(b, h) ((4 + (b) * 2 + (h)) * HTB)
#define PG8_STAGE(bufoff, gbase, voff) do { _Pragma("unroll") for (int _i = 0; _i < 2; ++_i) \
        __builtin_amdgcn_global_load_lds((const unsigned*)((const char*)(gbase) + (voff)[_i]), (PG8_LAS unsigned*)(lds + (bufoff) + ldsw + _i * 8192), 16, 0, 0); } while (0)
#define PG8_LDA(dst, b, h) do { _Pragma("unroll") for (int m = 0; m < 4; ++m) _Pragma("unroll") for (int k = 0; k < 2; ++k) dst[m][k] = *(const PG8_LAS bf16x8*)(lds + PG8_SA(b, h) + aoff + m * 2048 + k * 1024); } while (0)
#define PG8_LDB(dst, b, h) do { _Pragma("unroll") for (int n = 0; n < 2; ++n) _Pragma("unroll") for (int k = 0; k < 2; ++k) dst[n][k] = *(const PG8_LAS bf16x8*)(lds + PG8_SB(b, h) + boff + n * 2048 + k * 1024); } while (0)
#define PG8_MMA(ai, bj, At, Bt) do { __builtin_amdgcn_s_setprio(1); _Pragma("unroll") for (int m = 0; m < 4; ++m) _Pragma("unroll") for (int n = 0; n < 2; ++n) _Pragma("unroll") for (int k = 0; k < 2; ++k) \
        acc[ai][bj][m][n] = __builtin_amdgcn_mfma_f32_16x16x32_bf16(Bt[n][k], At[m][k], acc[ai][bj][m][n], 0, 0, 0); __builtin_amdgcn_s_setprio(0); } while (0)
#define PG8_WAIT_V(n) asm volatile("s_waitcnt vmcnt(" #n ")" ::: "memory")
#define PG8_WAIT_L(n) asm volatile("s_waitcnt lgkmcnt(" #n ")" ::: "memory")
#define PG8_BAR __builtin_amdgcn_s_barrier()
#define PG8_SCHED __builtin_amdgcn_sched_barrier(0)
    Unit cur, nxt; int ui = 0;
    if (!S.next(0, cur)) return;
    f32x4 acc[2][2][4][2];
#pragma unroll
    for (int a = 0; a < 2; ++a)
#pragma unroll
        for (int b = 0; b < 2; ++b)
#pragma unroll
            for (int m = 0; m < 4; ++m)
#pragma unroll
                for (int n = 0; n < 2; ++n) acc[a][b][m][n] = (f32x4){0.f, 0.f, 0.f, 0.f};
    bf16x8 At[4][2], B0[2][2], B1[2][2];
    const char* cA = (const char*)g.A + (size_t)cur.pm * tstep; const char* cB = (const char*)g.Bt + (size_t)cur.pn * tstep;
    S.a_ready(cur);
    PG8_STAGE(PG8_SB(0, 0), cB, voffB); PG8_STAGE(PG8_SA(0, 0), cA, voffA); PG8_STAGE(PG8_SB(0, 1), cB + hstep, voffB); PG8_STAGE(PG8_SA(0, 1), cA + hstep, voffA);
    if (wr == 1) PG8_BAR;
    PG8_WAIT_V(4); PG8_BAR;
    PG8_STAGE(PG8_SB(1, 0), cB + kstep, voffB); PG8_STAGE(PG8_SA(1, 0), cA + kstep, voffA); PG8_STAGE(PG8_SB(1, 1), cB + hstep + kstep, voffB);
    PG8_WAIT_V(6); PG8_BAR;
    PG8_STAMP();
    for (;;) {
        const bool has_next = S.next(ui + 1, nxt);
        const char* nA = has_next ? (const char*)g.A + (size_t)nxt.pm * tstep : cA; const char* nB = has_next ? (const char*)g.Bt + (size_t)nxt.pn * tstep : cB;
        for (int t = 0; t < nt; t += 2) {
            const bool last = (t == nt - 2);
            const char* a1 = cA + (size_t)(t + 1) * kstep;
            const char* a2 = last ? nA : cA + (size_t)(t + 2) * kstep; const char* b2 = last ? nB : cB + (size_t)(t + 2) * kstep;
            const char* a3 = a2 + kstep; const char* b3 = b2 + kstep;
            if (last && has_next) S.a_ready(nxt);
            PG8_LDB(B0, 0, 0); PG8_SCHED; PG8_LDA(At, 0, 0); PG8_STAGE(PG8_SA(1, 1), a1 + hstep, voffA);
            PG8_WAIT_L(8); PG8_BAR; PG8_WAIT_L(0); PG8_MMA(0, 0, At, B0); PG8_BAR; PG8_SCHED;
            PG8_LDB(B1, 0, 1); PG8_STAGE(PG8_SB(0, 0), b2, voffB);
            PG8_BAR; PG8_WAIT_L(0); PG8_MMA(0, 1, At, B1); PG8_BAR;
            PG8_LDA(At, 0, 1); PG8_STAGE(PG8_SA(0, 0), a2, voffA);
            PG8_BAR; PG8_WAIT_L(0); PG8_MMA(1, 0, At, B0); PG8_BAR; PG8_SCHED;
            PG8_STAGE(PG8_SB(0, 1), b2 + hstep, voffB);
            PG8_WAIT_V(6); PG8_BAR; PG8_MMA(1, 1, At, B1); PG8_BAR;
            PG8_LDB(B0, 1, 0); PG8_SCHED; PG8_LDA(At, 1, 0); PG8_STAGE(PG8_SA(0, 1), a2 + hstep, voffA);
            PG8_WAIT_L(8); PG8_BAR; PG8_WAIT_L(0); PG8_MMA(0, 0, At, B0); PG8_BAR; PG8_SCHED;
            PG8_LDB(B1, 1, 1); PG8_STAGE(PG8_SB(1, 0), b3, voffB);
            PG8_BAR; PG8_WAIT_L(0); PG8_MMA(0, 1, At, B1); PG8_BAR;
            PG8_LDA(At, 1, 1); PG8_STAGE(PG8_SA(1, 0), a3, voffA);
            PG8_BAR; PG8_WAIT_L(0); PG8_MMA(1, 0, At, B0); PG8_BAR; PG8_SCHED;
            PG8_STAGE(PG8_SB(1, 1), b3 + hstep, voffB);
            PG8_WAIT_V(6); PG8_BAR; PG8_MMA(1, 1, At, B1); PG8_BAR;
        }
        PG8_STAMP();
        if constexpr (!Epi::AFTER_DRAIN) { E(acc, cur, wr, wc, fr, fq); S.done(cur); }
        PG8_STAMP();
        if (!has_next) break;
#pragma unroll
        for (int a = 0; a < 2; ++a)
#pragma unroll
            for (int b = 0; b < 2; ++b)
#pragma unroll
                for (int m = 0; m < 4; ++m)
#pragma unroll
                    for (int n = 0; n < 2; ++n) acc[a][b][m][n] = (f32x4){0.f, 0.f, 0.f, 0.f};
        cur = nxt; cA = nA; cB = nB; ++ui;
    }
    PG8_WAIT_V(0);
    if (wr == 0) PG8_BAR;
    PG8_BAR;
    if constexpr (Epi::AFTER_DRAIN) { E.fused(acc, cur, wr, wc, fr, fq, lds, wid, lane); S.done(cur); }
    PG8_STAMP();
    if (STAMP && wid == 0) { stamps[lane] = lane < nts ? (((unsigned long long)(unsigned)ts_hi << 32) | (unsigned)ts_lo) : 0ull;
        if (lane == 62) stamps[62] = rt_entry; if (lane == 63) stamps[63] = (unsigned long long)wall_clock64(); }
#undef PG8_STAMP
#undef PG8_SA
#undef PG8_SB
#undef PG8_STAGE
#undef PG8_LDA
#undef PG8_LDB
#undef PG8_MMA
#undef PG8_WAIT_V
#undef PG8_WAIT_L
#undef PG8_BAR
#undef PG8_SCHED
}
}


struct OrderStd {
  int nM, nN, nwg, G, c, mode, r;
  DI void init(int nM_, int nN_, int G_, int c_, int mode_, int r_) { nM = nM_; nN = nN_; nwg = nM * nN; G = G_; c = c_; mode = mode_; r = r_; }
  DI bool next(int i, pg8::Unit& u) const {
    const long Lx = (long)i * G + c;
    if (Lx >= nwg) return false;
    int wgid = (int)Lx;
    { const int q = nwg / 8, rr = nwg % 8, xcd = wgid % 8, off = wgid / 8; wgid = (xcd < rr ? xcd * (q + 1) : rr * (q + 1) + (xcd - rr) * q) + off; }
    const int nig = 8 * nN, gid = wgid / nig, fm = gid * 8, gsz = (nM - fm) < 8 ? (nM - fm) : 8;
    u.pm = fm + ((wgid % nig) % gsz);
    u.pn = (wgid % nig) / gsz;
    if (mode == 1) u.pm = (u.pm < 16) ? u.pm + 16 * r : 32 + 64 * r + (u.pm - 16);
    return true;
  }
  DI void a_ready(const pg8::Unit&) const {}
  DI void done(const pg8::Unit&) const {}
};
struct OrderOne {
  int idx, count, mtiles;
  DI bool next(int i, pg8::Unit& u) const {
    if (i != 0 || idx < 0 || idx >= count) return false;
    u.pm = __builtin_amdgcn_readfirstlane(idx % mtiles);
    u.pn = __builtin_amdgcn_readfirstlane(idx / mtiles);
    return true;
  }
  DI void a_ready(const pg8::Unit&) const {}
  DI void done(const pg8::Unit&) const {}
};

DI int rowmap(int mode, int n) {
  if (mode == 0) return n;
  if (mode == 1) return (n >> 4) * 32 + (n & 15);
  if (mode == 2) return (n >> 4) * 32 + 16 + (n & 15);
  return 2816 + (n - 2304);
}
DI void transpose_item(char* smem, const float* __restrict__ W, int ldw, int k0, int n0, int nvalid, u16* dst, int ldd, int mode) {
  float* tile = (float*)smem;
  const int tid = opaque_tid(), tx = tid & 63, ty = tid >> 6;
  for (int r = ty; r < 64; r += 4) tile[r * 65 + tx] = (tx < nvalid) ? W[(size_t)(k0 + r) * ldw + n0 + tx] : 0.f;
  __syncthreads();
  const int n = tid >> 2, kq = tid & 3;
  if (n < nvalid) {
    unsigned pk[8];
#pragma unroll
    for (int j = 0; j < 8; ++j) pk[j] = pack2bf(tile[(kq * 16 + 2 * j) * 65 + n], tile[(kq * 16 + 2 * j + 1) * 65 + n]);
    u16* d = dst + (size_t)rowmap(mode, n0 + n) * ldd + k0 + kq * 16;
    *(uint4*)d = uint4{pk[0], pk[1], pk[2], pk[3]};
    *(uint4*)(d + 8) = uint4{pk[4], pk[5], pk[6], pk[7]};
  }
  __syncthreads();
}

DI void fold_item(char* smem, const Params& p, int l, int it) {
  float* tile = (float*)smem;
  float* trig = tile + 64 * 65;
  const int tid = opaque_tid(), tx = tid & 63, ty = tid >> 6;
  const int wg = it >> 4, which = wg >> 2, g = wg & 3, k0 = (it & 15) * 64;
  const float* W = p.w_in + (size_t)l * 1024 * 2576;
  for (int r = ty; r < 64; r += 4) tile[r * 65 + tx] = W[(size_t)(k0 + r) * 2576 + 2320 + g * 64 + tx];
  if (tid < 64) {
    float s, c;
    sincospif((float)tid / 32.f, &s, &c);
    trig[tid] = which ? s : c;
  }
  __syncthreads();
  const int kc = tid & 63, kq = tid >> 6;
  float acc[16];
#pragma unroll
  for (int j = 0; j < 16; ++j) acc[j] = 0.f;
  for (int cidx = 0; cidx < 64; ++cidx) {
    const float t = trig[(cidx * kc) & 63];
#pragma unroll
    for (int j = 0; j < 16; ++j) acc[j] += tile[(kq * 16 + j) * 65 + cidx] * t;
  }
  u16* dst = (u16*)(p.ws + OFF_INT + (size_t)l * SZ_INT) + (size_t)(2304 + which * 256 + g * 64 + kc) * 1024 + k0 + kq * 16;
  unsigned pk[8];
#pragma unroll
  for (int j = 0; j < 8; ++j) pk[j] = pack2bf(acc[2 * j], acc[2 * j + 1]);
  *(uint4*)dst = uint4{pk[0], pk[1], pk[2], pk[3]};
  *(uint4*)(dst + 8) = uint4{pk[4], pk[5], pk[6], pk[7]};
  __syncthreads();
}

DI void dft_row_item(const Params& p, int it) {
  const int L = 256;
  const int kL = it;
  u16* row = (u16*)(p.ws + OFF_DFTC) + (size_t)kL * 2 * L;
  const float inv = 2.f / (float)L;
  for (int cch = (otid() & 255); cch < L / 8; cch += 256) {
    unsigned pc[4], ps[4];
#pragma unroll
    for (int j = 0; j < 4; ++j) {
      float s0, c0, s1, c1;
      const int l0 = cch * 8 + 2 * j;
      sincospif((float)((kL * l0) & (L - 1)) * inv, &s0, &c0);
      sincospif((float)((kL * (l0 + 1)) & (L - 1)) * inv, &s1, &c1);
      pc[j] = pack2bf(c0, c1);
      ps[j] = pack2bf(-s0, -s1);
    }
    *(uint4*)(row + cch * 8) = uint4{pc[0], pc[1], pc[2], pc[3]};
    *(uint4*)(row + L + cch * 8) = uint4{ps[0], ps[1], ps[2], ps[3]};
  }
}

DI void rope_item(const Params& p, int it) {
  if (it >= 4) {
    const int e = (it - 4) * 256 + (otid() & 255);
    const int k = e >> 6, l = e & 63;
    float s, c;
    sincospif((float)((k * l) & 63) / 32.f, &s, &c);
    u16* CS = (u16*)(p.ws + OFF_FFT);
    CS[e] = (u16)f2bf(c);
    CS[4096 + e] = (u16)f2bf(s);
    float s2, c2;
    sincospif((float)(k * l) / 2048.f, &s2, &c2);
    float* TW = (float*)(p.ws + OFF_FFT + 16384);
    TW[e * 2] = c2;
    TW[e * 2 + 1] = s2;
    return;
  }
  const int e = it * 256 + (otid() & 255);
  const int pos = e >> 4, i = e & 15;
  const float inv_freq = powf(10000.f, -(float)i / 16.f);
  const float ang = (float)pos * inv_freq;
  float* rope = (float*)(p.ws + OFF_ROPE);
  rope[e * 2] = cosf(ang);
  rope[e * 2 + 1] = sinf(ang);
}

DI void mod_item(char* smem, const Params& p, int it) {
  const int l = it / 144, cb = it % 144, n0 = cb * 64;
  float* sc = (float*)smem;
  float* red = (float*)(smem + 36864);
  const int tid = opaque_tid();
  for (int e = tid; e < 9216; e += 256) {
    const int v = e >> 10, k = e & 1023;
    const float val = v == 0 ? p.c_ctx[k] : p.c[(v - 1) * 1024 + k];
    sc[e] = siluf(val);
  }
  __syncthreads();
  const int kg = tid >> 4, c4 = tid & 15;
  float acc[9][4];
#pragma unroll
  for (int v = 0; v < 9; ++v)
#pragma unroll
    for (int j = 0; j < 4; ++j) acc[v][j] = 0.f;
  const float* W = p.mod_w + (size_t)l * 1024 * 9216 + n0 + c4 * 4;
#pragma unroll 4
  for (int kk = 0; kk < 64; ++kk) {
    const int k = kg * 64 + kk;
    const float4 wv = *(const float4*)(W + (size_t)k * 9216);
#pragma unroll
    for (int v = 0; v < 9; ++v) {
      const float s = sc[v * 1024 + k];
      acc[v][0] += s * wv.x; acc[v][1] += s * wv.y; acc[v][2] += s * wv.z; acc[v][3] += s * wv.w;
    }
  }
#pragma unroll
  for (int v = 0; v < 9; ++v)
#pragma unroll
    for (int j = 0; j < 4; ++j) red[(kg * 9 + v) * 64 + c4 * 4 + j] = acc[v][j];
  __syncthreads();
  float* MOD = (float*)(p.ws + OFF_MOD);
  for (int e = tid; e < 576; e += 256) {
    const int v = e >> 6, cc = e & 63;
    float s = p.mod_b[l * 9216 + n0 + cc];
#pragma unroll
    for (int q = 0; q < 16; ++q) s += red[(q * 9 + v) * 64 + cc];
    MOD[(size_t)(l * 9 + v) * 9216 + n0 + cc] = s;
  }
  __syncthreads();
}

DI void phase_init(char* smem0, const Params& p, int bid0, int nb0) {
  constexpr int N_T = 10144, N_F = 256, N_D = 256, N_R = 20, N_M = 288;
  const int vb = otid() >> 8;
  char* smem = smem0 + vb * VSM;
  const int bid = bid0 * 2 + vb, nb = nb0 * 2;
  { const int t0 = otid(); if (bid0 == 0) { if (t0 < 64) ((int*)(p.ws + OFF_CTR))[t0] = 0; for (int i = t0; i < 3456; i += 512) ((unsigned*)(p.ws + OFF_BAR))[i] = 0u; } }
  for (int it = bid; it < N_T + N_F + N_D + N_R + N_M; it += nb) {
    if (it < N_T) {
      const int l = it / 5072, j = it % 5072;
      if (j < 4224) {
        const int f = j / 2112, jj = j % 2112, m = jj / 704, q = jj % 704;
        const float* w1 = (f ? p.ffn2_w1 : p.ffn1_w1) + (size_t)l * 1024 * 2816;
        const float* w3 = (f ? p.ffn2_w3 : p.ffn1_w3) + (size_t)l * 1024 * 2816;
        const float* w2 = (f ? p.ffn2_w2 : p.ffn1_w2) + (size_t)l * 2816 * 1024;
        if (m < 2) {
          u16* dst = (u16*)(p.ws + OFF_UPT + (size_t)(l * 2 + f) * SZ_UPT);
          transpose_item(smem, m ? w3 : w1, 2816, (q / 44) * 64, (q % 44) * 64, 64, dst, 1024, m ? 2 : 1);
        } else {
          u16* dst = (u16*)(p.ws + OFF_DNT + (size_t)(l * 2 + f) * SZ_DNT);
          transpose_item(smem, w2, 1024, (q / 16) * 64, (q % 16) * 64, 64, dst, 2816, 0);
        }
      } else if (j < 4816) {
        const int q = j - 4224, kt = q / 37, nt = q % 37;
        u16* dst = (u16*)(p.ws + OFF_INT + (size_t)l * SZ_INT);
        transpose_item(smem, p.w_in + (size_t)l * 1024 * 2576, 2576, kt * 64, nt * 64, nt < 36 ? 64 : 16, dst, 1024, nt < 36 ? 0 : 3);
      } else {
        const int q = j - 4816;
        u16* dst = (u16*)(p.ws + OFF_OUTT + (size_t)l * SZ_OUTT);
        transpose_item(smem, p.w_out + (size_t)l * 1024 * 1024, 1024, (q / 16) * 64, (q % 16) * 64, 64, dst, 1024, 0);
      }
    } else if (it < N_T + N_F) {
      const int j = it - N_T;
      fold_item(smem, p, j >> 7, j & 127);
    } else if (it < N_T + N_F + N_D) {
      dft_row_item(p, it - N_T - N_F);
    } else if (it < N_T + N_F + N_D + N_R) {
      rope_item(p, it - N_T - N_F - N_D);
    } else {
      mod_item(smem, p, it - N_T - N_F - N_D - N_R);
    }
  }
}

DI const float* xsrc_row(const Params& p, bool from_in, int grow) {
  if (from_in) return grow < 8192 ? p.x_prompt + (size_t)grow * 1024 : p.x_sample + (size_t)(grow - 8192) * 1024;
  return p.out + (size_t)grow * 1024;
}
DI float wave_sum(float v) {
#pragma unroll
  for (int o = 32; o > 0; o >>= 1) v += sx(v, o);
  return v;
}
DI float4 ntload4(const float* p) { const f32x4 v = __builtin_nontemporal_load((const f32x4*)p); return float4{v[0], v[1], v[2], v[3]}; }
DI void ntstore4(float* p, float4 v) { __builtin_nontemporal_store(f32x4{v.x, v.y, v.z, v.w}, (f32x4*)p); }
DI void phase_norm(const Params& p, int l, int which, int bid, int nb) {
  const int t0 = otid(); const int lane = t0 & 63, w = t0 >> 6;
  const float* gain = (which == 0 ? p.norm_ffn1 : which == 1 ? p.norm_mix : p.norm_ffn2) + l * 1024;
  const float* MOD = (const float*)(p.ws + OFF_MOD);
  u16* H = (u16*)(p.ws + OFF_H);
  const bool from_in = (l == 0 && which == 0);
  const int stride = nb * 8;
  for (int row = bid * 8 + w; row < 40960; row += 2 * stride) {
    const int row2 = row + stride;
    const bool has2 = row2 < 40960;
    const float* xa = xsrc_row(p, from_in, row);
    const float* xb = xsrc_row(p, from_in, has2 ? row2 : row);
    float4 va[4], vb[4];
    float sa = 0.f, sb = 0.f;
#pragma unroll
    for (int i = 0; i < 4; ++i) { va[i] = ntload4(xa + i * 256 + lane * 4); vb[i] = ntload4(xb + i * 256 + lane * 4); }
#pragma unroll
    for (int i = 0; i < 4; ++i) {
      sa += va[i].x * va[i].x + va[i].y * va[i].y + va[i].z * va[i].z + va[i].w * va[i].w;
      sb += vb[i].x * vb[i].x + vb[i].y * vb[i].y + vb[i].z * vb[i].z + vb[i].w * vb[i].w;
    }
#pragma unroll
    for (int o = 32; o > 0; o >>= 1) { sa += sx(sa, o); sb += sx(sb, o); }
    const float ra = rsqrtf(sa * (1.f / 1024.f) + 1e-6f), rb = rsqrtf(sb * (1.f / 1024.f) + 1e-6f);
    const float* mva = MOD + (size_t)(l * 9 + modv_of(row)) * 9216 + which * 3 * 1024;
    const float* mvb = MOD + (size_t)(l * 9 + modv_of(has2 ? row2 : row)) * 9216 + which * 3 * 1024;
#pragma unroll
    for (int i = 0; i < 4; ++i) {
      const int k = i * 256 + lane * 4;
      const float4 gv = *(const float4*)(gain + k);
      {
        const float4 sh = *(const float4*)(mva + k);
        const float4 scv = *(const float4*)(mva + 1024 + k);
        const float h0 = va[i].x * ra * gv.x * (1.f + scv.x) + sh.x;
        const float h1 = va[i].y * ra * gv.y * (1.f + scv.y) + sh.y;
        const float h2 = va[i].z * ra * gv.z * (1.f + scv.z) + sh.z;
        const float h3 = va[i].w * ra * gv.w * (1.f + scv.w) + sh.w;
        *(uint2*)(H + (size_t)row * 1024 + k) = uint2{pack2bf(h0, h1), pack2bf(h2, h3)};
      }
      if (has2) {
        const float4 sh = *(const float4*)(mvb + k);
        const float4 scv = *(const float4*)(mvb + 1024 + k);
        const float h0 = vb[i].x * rb * gv.x * (1.f + scv.x) + sh.x;
        const float h1 = vb[i].y * rb * gv.y * (1.f + scv.y) + sh.y;
        const float h2 = vb[i].z * rb * gv.z * (1.f + scv.z) + sh.z;
        const float h3 = vb[i].w * rb * gv.w * (1.f + scv.w) + sh.w;
        *(uint2*)(H + (size_t)row2 * 1024 + k) = uint2{pack2bf(h0, h1), pack2bf(h2, h3)};
      }
    }
  }
}
DI void phase_final(const Params& p, int bid, int nb) {
  const int t0 = otid(); const int lane = t0 & 63, w = t0 >> 6;
  const int stride = nb * 8;
  for (int row = bid * 8 + w; row < 40960; row += 2 * stride) {
    const int row2 = row + stride;
    const bool has2 = row2 < 40960;
    float* xa = p.out + (size_t)row * 1024;
    float* xb = p.out + (size_t)(has2 ? row2 : row) * 1024;
    float4 va[4], vb[4];
    float sa = 0.f, sb = 0.f;
#pragma unroll
    for (int i = 0; i < 4; ++i) { va[i] = ntload4(xa + i * 256 + lane * 4); vb[i] = ntload4(xb + i * 256 + lane * 4); }
#pragma unroll
    for (int i = 0; i < 4; ++i) {
      sa += va[i].x * va[i].x + va[i].y * va[i].y + va[i].z * va[i].z + va[i].w * va[i].w;
      sb += vb[i].x * vb[i].x + vb[i].y * vb[i].y + vb[i].z * vb[i].z + vb[i].w * vb[i].w;
    }
#pragma unroll
    for (int o = 32; o > 0; o >>= 1) { sa += sx(sa, o); sb += sx(sb, o); }
    const float ra = rsqrtf(sa * (1.f / 1024.f) + 1e-6f), rb = rsqrtf(sb * (1.f / 1024.f) + 1e-6f);
#pragma unroll
    for (int i = 0; i < 4; ++i) {
      const int k = i * 256 + lane * 4;
      const float4 gv = *(const float4*)(p.final_norm + k);
      ntstore4(xa + k, float4{va[i].x * ra * gv.x, va[i].y * ra * gv.y, va[i].z * ra * gv.z, va[i].w * ra * gv.w});
      if (has2) ntstore4(xb + k, float4{vb[i].x * rb * gv.x, vb[i].y * rb * gv.y, vb[i].z * rb * gv.z, vb[i].w * rb * gv.w});
    }
  }
}

struct EpiUp {
  static constexpr bool PERM = false, AFTER_DRAIN = false;
  u16* ACT;
  DI void operator()(const f32x4 (&acc)[2][2][4][2], const pg8::Unit& u, int wr, int wc, int fr, int fq) const {
    const int row0 = u.pm * 256 + wr * 64 + fr;
#pragma unroll
    for (int ai = 0; ai < 2; ++ai)
#pragma unroll
      for (int m = 0; m < 4; ++m) {
        u16* rowp = ACT + (size_t)(row0 + ai * 128 + m * 16) * 2816 + 4 * fq;
#pragma unroll
        for (int bj = 0; bj < 2; ++bj) {
          const f32x4 a = acc[ai][bj][m][0], b = acc[ai][bj][m][1];
          const int col = (u.pn * 256 + bj * 128 + wc * 32) >> 1;
          *(uint2*)(rowp + col) = uint2{pg8::cvt_pk_bf16(siluf(a[0]) * b[0], siluf(a[1]) * b[1]), pg8::cvt_pk_bf16(siluf(a[2]) * b[2], siluf(a[3]) * b[3])};
        }
      }
  }
};
struct EpiResid {
  static constexpr bool PERM = false, AFTER_DRAIN = false;
  const float* xp; const float* xs; float* out; const float* gate;
  float coef; int from_in;
  DI void operator()(const f32x4 (&acc)[2][2][4][2], const pg8::Unit& u, int wr, int wc, int fr, int fq) const {
    const int row0 = u.pm * 256 + wr * 64 + fr, col0 = u.pn * 256 + wc * 32 + 4 * fq;
    const float* gv = gate + (size_t)modv_of(u.pm * 256) * 9216 + col0;
    f32x4 g4[2][2];
#pragma unroll
    for (int bj = 0; bj < 2; ++bj)
#pragma unroll
      for (int n = 0; n < 2; ++n) g4[bj][n] = *(const f32x4*)(gv + bj * 128 + n * 16) * coef;
#pragma unroll
    for (int ai = 0; ai < 2; ++ai)
#pragma unroll
      for (int m = 0; m < 4; ++m) {
        const int row = row0 + ai * 128 + m * 16;
        const float* xr = (from_in ? (row < 8192 ? xp + (size_t)row * 1024 : xs + (size_t)(row - 8192) * 1024) : out + (size_t)row * 1024) + col0;
        float* orow = out + (size_t)row * 1024 + col0;
#pragma unroll
        for (int bj = 0; bj < 2; ++bj)
#pragma unroll
          for (int n = 0; n < 2; ++n) {
            const f32x4 xv = *(const f32x4*)(xr + bj * 128 + n * 16);
            *(f32x4*)(orow + bj * 128 + n * 16) = xv + g4[bj][n] * acc[ai][bj][m][n];
          }
      }
  }
};
struct EpiProj {
  static constexpr bool PERM = false, AFTER_DRAIN = false;
  u16* P; float* GATES; u16* XTC; u16* XTL; int r;
  DI void operator()(const f32x4 (&acc)[2][2][4][2], const pg8::Unit& u, int wr, int wc, int fr, int fq) const {
    const int lt = u.pm < 32 ? u.pm - 16 * r : 16 + (u.pm - 32 - 64 * r);
    const int u0 = lt * 256 + wr * 64 + fr;
    if (u.pn < 9 || (u.pn < 11 && lt >= 16)) {
#pragma unroll
      for (int ai = 0; ai < 2; ++ai)
#pragma unroll
        for (int m = 0; m < 4; ++m) {
          u16* rowp = P + (size_t)(u0 + ai * 128 + m * 16) * PW + u.pn * 256 + wc * 32 + 4 * fq;
#pragma unroll
          for (int bj = 0; bj < 2; ++bj)
#pragma unroll
            for (int n = 0; n < 2; ++n) {
              const f32x4 a = acc[ai][bj][m][n];
              *(uint2*)(rowp + bj * 128 + n * 16) = uint2{pg8::cvt_pk_bf16(a[0], a[1]), pg8::cvt_pk_bf16(a[2], a[3])};
            }
        }
    } else if (u.pn < 11) {
      const int which = u.pn - 9;
      const bool isl = lt >= 16;
      const int ld = isl ? 8192 : 512;
      const int tl = isl ? lt - 16 : lt;
      const int bq = isl ? (tl >> 4) : tl;
      const int lp0 = isl ? (tl & 15) * 256 : 0;
      u16* d0 = (isl ? XTL : XTC) + (size_t)bq * 256 * ld + which * (ld >> 1) + lp0;
      const int lane_off = wr * 64 + fr + (wc * 32 + 4 * fq) * ld;
#pragma unroll
      for (int ai = 0; ai < 2; ++ai)
#pragma unroll
        for (int m = 0; m < 4; ++m)
#pragma unroll
          for (int bj = 0; bj < 2; ++bj)
#pragma unroll
            for (int n = 0; n < 2; ++n) {
              const f32x4 a = acc[ai][bj][m][n];
#pragma unroll
              for (int j = 0; j < 4; ++j) d0[lane_off + ai * 128 + m * 16 + (bj * 128 + n * 16 + j) * ld] = (u16)f2bf(a[j]);
            }
    } else {
      if (wc == 0) {
#pragma unroll
        for (int ai = 0; ai < 2; ++ai)
#pragma unroll
          for (int m = 0; m < 4; ++m) {
            const f32x4 a = acc[ai][0][m][0];
            *(f32x4*)(GATES + (size_t)(u0 + ai * 128 + m * 16) * 16 + 4 * fq) = a;
          }
      }
    }
  }
};
struct EpiFourier {
  static constexpr bool PERM = false, AFTER_DRAIN = false;
  u16* M; int r, lat; float scale;
  DI void operator()(const f32x4 (&acc)[2][2][4][2], const pg8::Unit& u, int wr, int wc, int fr, int fq) const {
    const int useq = lat ? 4096 + u.pn * 4096 : u.pn * 256;
    const int u0 = useq + u.pm * 256 + wr * 64 + fr;
#pragma unroll
    for (int ai = 0; ai < 2; ++ai)
#pragma unroll
      for (int m = 0; m < 4; ++m) {
        u16* rowp = M + (size_t)grow_of(u0 + ai * 128 + m * 16, r) * 1024 + 768 + wc * 32 + 4 * fq;
#pragma unroll
        for (int bj = 0; bj < 2; ++bj)
#pragma unroll
          for (int n = 0; n < 2; ++n) {
            const f32x4 a = acc[ai][bj][m][n] * scale;
            *(uint2*)(rowp + bj * 128 + n * 16) = uint2{pg8::cvt_pk_bf16(a[0], a[1]), pg8::cvt_pk_bf16(a[2], a[3])};
          }
      }
  }
};

struct EpiFourierPart {
  static constexpr bool PERM = false, AFTER_DRAIN = false;
  u16* FP; float scale; int kh;
  DI void operator()(const f32x4 (&acc)[2][2][4][2], const pg8::Unit& u, int wr, int wc, int fr, int fq) const {
    const int mt = u.pm;
    u16* base = FP + ((size_t)(kh * 4 + u.pn) * 2304 + mt * 256 + wr * 64 + fr) * 256 + wc * 32 + 4 * fq;
#pragma unroll
    for (int ai = 0; ai < 2; ++ai)
#pragma unroll
      for (int m = 0; m < 4; ++m) {
        u16* rowp = base + (size_t)(ai * 128 + m * 16) * 256;
#pragma unroll
        for (int bj = 0; bj < 2; ++bj)
#pragma unroll
          for (int n = 0; n < 2; ++n) {
            const f32x4 a = acc[ai][bj][m][n] * scale;
            *(uint2*)(rowp + bj * 128 + n * 16) = uint2{pg8::cvt_pk_bf16(a[0], a[1]), pg8::cvt_pk_bf16(a[2], a[3])};
          }
      }
  }
};
struct OrderF {
  int idx, rem;
  DI bool next(int i, pg8::Unit& u) const {
    if (i != 0 || idx >= 72) return false;
    u.pm = __builtin_amdgcn_readfirstlane(rem % 9);
    u.pn = __builtin_amdgcn_readfirstlane(rem / 9);
    return true;
  }
  DI void a_ready(const pg8::Unit&) const {}
  DI void done(const pg8::Unit&) const {}
};
DI void phase_up(char* smem, const Params& p, int l, int f, int bid, int nb) {
  pg8::Gemm g{(const u16*)(p.ws + OFF_H), (const u16*)(p.ws + OFF_UPT + (size_t)(l * 2 + f) * SZ_UPT), 40960, 5632, 1024, 1024};
  OrderStd S; S.init(160, 22, nb, bid, 0, 0);
  EpiUp E{(u16*)(p.ws + OFF_ACT)};
  pg8::gemm_phase<EpiUp, OrderStd, false>((PG8_LAS unsigned char*)smem, g, S, E, nullptr);
}
DI void phase_resid(char* smem, const Params& p, const u16* A, const u16* Wt, int K, int l, int gate_chunk, float coef, bool from_in, int bid, int nb) {
  pg8::Gemm g{A, Wt, 40960, 1024, K, K};
  OrderStd S; S.init(160, 4, nb, bid, 0, 0);
  EpiResid E{p.x_prompt, p.x_sample, p.out, (const float*)(p.ws + OFF_MOD) + (size_t)l * 9 * 9216 + gate_chunk * 1024, coef, from_in ? 1 : 0};
  pg8::gemm_phase<EpiResid, OrderStd, false>((PG8_LAS unsigned char*)smem, g, S, E, nullptr);
}
DI void phase_proj(char* smem, const Params& p, int l, int r, int bid, int nb) {
  pg8::Gemm g{(const u16*)(p.ws + OFF_H), (const u16*)(p.ws + OFF_INT + (size_t)l * SZ_INT), 40960, 3072, 1024, 1024};
  OrderStd S; S.init(80, 12, nb, bid, 1, r);
  EpiProj E{(u16*)(p.ws + OFF_P), (float*)(p.ws + OFF_GATES), (u16*)(p.ws + OFF_XTC), (u16*)(p.ws + OFF_XTL), r};
  pg8::gemm_phase<EpiProj, OrderStd, false>((PG8_LAS unsigned char*)smem, g, S, E, nullptr);
}

DI void load64(const u16* src, float* v) {
#pragma unroll
  for (int i = 0; i < 8; ++i) unpack8(*(const uint4*)(src + i * 8), v + i * 8);
}
DI void store64(u16* dst, const float* v) {
#pragma unroll
  for (int i = 0; i < 8; ++i)
    *(uint4*)(dst + i * 8) = uint4{pack2bf(v[i * 8], v[i * 8 + 1]), pack2bf(v[i * 8 + 2], v[i * 8 + 3]), pack2bf(v[i * 8 + 4], v[i * 8 + 5]), pack2bf(v[i * 8 + 6], v[i * 8 + 7])};
}
DI void rope64(const float* rope, int pos, float* v) {
  const float* rr = rope + (pos >> 6) * 32;
  const float* rc = rope + (pos & 63) * 32;
#pragma unroll
  for (int i = 0; i < 16; ++i) {
    const float c = rr[i * 2], s = rr[i * 2 + 1];
    const float a = v[i], b = v[16 + i];
    v[i] = a * c - b * s;
    v[16 + i] = b * c + a * s;
    const float c2 = rc[i * 2], s2 = rc[i * 2 + 1];
    const float a2 = v[32 + i], b2 = v[48 + i];
    v[32 + i] = a2 * c2 - b2 * s2;
    v[48 + i] = b2 * c2 + a2 * s2;
  }
}
DI void prep_attn_item(const Params& p, int l, int r, int item) {
  const int tid = opaque_tid(), tk = tid & 63, hh = tid >> 6;
  const int u = item * 64 + tk;
  const bool lat = u >= 4096;
  const u16* prow = (const u16*)(p.ws + OFF_P) + (size_t)u * PW;
  const float* rope = (const float*)(p.ws + OFF_ROPE);
  int bl, pos;
  if (!lat) { bl = u >> 8; pos = u & 255; } else { bl = (u - 4096) >> 12; pos = (u - 4096) & 4095; }
  float v[64];
  {
    load64(prow + hh * 64, v);
    float ss = 0.f;
#pragma unroll
    for (int d = 0; d < 64; ++d) ss += v[d] * v[d];
    const float rstd = rsqrtf(ss * (1.f / 64.f) + 1e-6f);
#pragma unroll
    for (int d = 0; d < 64; ++d) v[d] = v[d] * rstd * p.q_norm[l * 64 + d];
    if (lat) rope64(rope, pos, v);
#pragma unroll
    for (int d = 0; d < 64; ++d) v[d] *= 0.18033688011112042f;
    store64((u16*)(p.ws + OFF_QB) + ((size_t)u * 4 + hh) * 64, v);
  }
  const int kvh = hh & 1;
  if (hh < 2) {
    load64(prow + 256 + kvh * 64, v);
    float ss = 0.f;
#pragma unroll
    for (int d = 0; d < 64; ++d) ss += v[d] * v[d];
    const float rstd = rsqrtf(ss * (1.f / 64.f) + 1e-6f);
#pragma unroll
    for (int d = 0; d < 64; ++d) v[d] = v[d] * rstd * p.k_norm[l * 64 + d];
    if (!lat) {
      const int b = r * 16 + bl;
      float* o = p.out + OUT_K + ((size_t)((b * 2 + l) * 2 + kvh) * 256 + pos) * 64;
#pragma unroll
      for (int d = 0; d < 64; d += 4) *(float4*)(o + d) = float4{v[d], v[d + 1], v[d + 2], v[d + 3]};
      store64((u16*)(p.ws + OFF_KBC) + ((size_t)(bl * 2 + kvh) * 256 + pos) * 64, v);
    } else {
      rope64(rope, pos, v);
      store64((u16*)(p.ws + OFF_KBL) + ((size_t)(bl * 2 + kvh) * 4608 + 512 + pos) * 64, v);
    }
  } else {
    load64(prow + 384 + kvh * 64, v);
    if (!lat) {
      const int b = r * 16 + bl;
      float* o = p.out + OUT_V + ((size_t)((b * 2 + l) * 2 + kvh) * 256 + pos) * 64;
#pragma unroll
      for (int d = 0; d < 64; d += 4) *(float4*)(o + d) = float4{v[d], v[d + 1], v[d + 2], v[d + 3]};
      u16* vt = (u16*)(p.ws + OFF_VTC) + (size_t)(bl * 2 + kvh) * 64 * 256 + pos;
#pragma unroll
      for (int d = 0; d < 64; ++d) vt[(size_t)d * 256] = (u16)f2bf(v[d]);
    } else {
      u16* vt = (u16*)(p.ws + OFF_VTL) + (size_t)(bl * 2 + kvh) * 64 * 4608 + 512 + pos;
#pragma unroll
      for (int d = 0; d < 64; ++d) vt[(size_t)d * 4608] = (u16)f2bf(v[d]);
    }
  }
}
DI void prep_cache_item(const Params& p, int l, int r, int item) {
  const int bl = item >> 4, kvh = (item >> 3) & 1, pblk = item & 7;
  const int tid = opaque_tid(), pp = tid & 63, dq = tid >> 6;
  const int b = r * 4 + bl, pos = pblk * 64 + pp;
  const size_t src = ((size_t)((b * 2 + l) * 2 + kvh) * 512 + pos) * 64 + dq * 16;
  u16* kb = (u16*)(p.ws + OFF_KBL) + ((size_t)(bl * 2 + kvh) * 4608 + pos) * 64 + dq * 16;
  u16* vt = (u16*)(p.ws + OFF_VTL) + ((size_t)(bl * 2 + kvh) * 64 + dq * 16) * 4608 + pos;
  float kv[16], vv[16];
#pragma unroll
  for (int j = 0; j < 4; ++j) {
    const float4 a = *(const float4*)(p.cache_k + src + j * 4);
    const float4 c = *(const float4*)(p.cache_v + src + j * 4);
    kv[j * 4] = a.x; kv[j * 4 + 1] = a.y; kv[j * 4 + 2] = a.z; kv[j * 4 + 3] = a.w;
    vv[j * 4] = c.x; vv[j * 4 + 1] = c.y; vv[j * 4 + 2] = c.z; vv[j * 4 + 3] = c.w;
  }
  *(uint4*)kb = uint4{pack2bf(kv[0], kv[1]), pack2bf(kv[2], kv[3]), pack2bf(kv[4], kv[5]), pack2bf(kv[6], kv[7])};
  *(uint4*)(kb + 8) = uint4{pack2bf(kv[8], kv[9]), pack2bf(kv[10], kv[11]), pack2bf(kv[12], kv[13]), pack2bf(kv[14], kv[15])};
#pragma unroll
  for (int j = 0; j < 16; ++j) vt[(size_t)j * 4608] = (u16)f2bf(vv[j]);
}
DI void prep_convb_item(const Params& p, int l, int r, int item) {
  const int idx = item * 256 + (otid() & 255);
  const int u = idx >> 5, c0 = (idx & 31) * 8;
  const u16* P = (const u16*)(p.ws + OFF_P);
  const int pos = u < 4096 ? (u & 255) : ((u - 4096) & 4095);
  const int L = u < 4096 ? 256 : 4096;
  const float* cw = p.conv_b_w + l * 768;
  float gb[8], gc[8], xb[8], y[8];
  unpack8(*(const uint4*)(P + (size_t)u * PW + 512 + c0), gb);
#pragma unroll
  for (int j = 0; j < 8; ++j) y[j] = 0.f;
#pragma unroll
  for (int dt = 0; dt < 3; ++dt) {
    const int pp = pos + dt - 1;
    if (pp >= 0 && pp < L) {
      const size_t ro = (size_t)(u + dt - 1) * PW;
      unpack8(*(const uint4*)(P + ro + 768 + c0), gc);
      unpack8(*(const uint4*)(P + ro + 1024 + c0), xb);
#pragma unroll
      for (int j = 0; j < 8; ++j) y[j] += gc[j] * xb[j] * cw[dt * 256 + c0 + j];
    }
  }
  u16* M = (u16*)(p.ws + OFF_H) + (size_t)grow_of(u, r) * 1024 + 256 + c0;
  *(uint4*)M = uint4{pack2bf(gb[0] * y[0], gb[1] * y[1]), pack2bf(gb[2] * y[2], gb[3] * y[3]), pack2bf(gb[4] * y[4], gb[5] * y[5]), pack2bf(gb[6] * y[6], gb[7] * y[7])};
}

DI void prep_delta_item(char* smem, const Params& p, int l, int r, int item) {
  const int cpos = item >> 2, h = item & 3;
  const int tid = opaque_tid(), lane = tid & 63, w = tid >> 6, l15 = lane & 15, g = lane >> 4;
  u16* sQ = (u16*)smem;
  u16* sK = sQ + 4608;
  u16* sV = sK + 4608;
  float* sL = (float*)(smem + 27648);
  float* sGc = (float*)(smem + 27648 + 36864);
  float* sBeta = sGc + 128;
  const int u0 = cpos * 64;
  const bool lat = u0 >= 4096;
  const int L = lat ? 4096 : 256;
  const int ul = lat ? u0 - 4096 : u0;
  const int bl = lat ? (ul >> 12) : (ul >> 8);
  const int n = (ul & (L - 1)) >> 6;
  const int NC = L >> 6;
  const u16* P = (const u16*)(p.ws + OFF_P);
  const float* GATES = (const float*)(p.ws + OFF_GATES);
  {
    const int i = tid >> 2, dq = tid & 3;
    const int u = u0 + i;
    const int pos = (ul & (L - 1)) + i;
    const float* cw = p.conv_c_w + l * 3 * 768;
#pragma unroll 1
    for (int which = 0; which < 3; ++which) {
      const int ch = which * 256 + h * 64 + dq * 16;
      float y[16];
#pragma unroll
      for (int j = 0; j < 16; ++j) y[j] = 0.f;
#pragma unroll
      for (int dt = 0; dt < 3; ++dt) {
        const int pp = pos + dt - 1;
        if (pp >= 0 && pp < L) {
          float xin[16];
          const u16* src = P + (size_t)(u + dt - 1) * PW + 1280 + ch;
          unpack8(*(const uint4*)src, xin);
          unpack8(*(const uint4*)(src + 8), xin + 8);
#pragma unroll
          for (int j = 0; j < 16; ++j) y[j] += xin[j] * cw[dt * 768 + ch + j];
        }
      }
      float ss = 0.f;
#pragma unroll
      for (int j = 0; j < 16; ++j) { y[j] = siluf(y[j]); ss += y[j] * y[j]; }
      if (which < 2) {
        ss += sx(ss, 1);
        ss += sx(ss, 2);
        const float sc = rsqrtf(ss + 1e-6f) * (which == 0 ? 0.125f : 1.f);
#pragma unroll
        for (int j = 0; j < 16; ++j) y[j] *= sc;
      }
      u16* dst = (which == 0 ? sQ : which == 1 ? sK : sV) + i * 72 + dq * 16;
      *(uint4*)dst = uint4{pack2bf(y[0], y[1]), pack2bf(y[2], y[3]), pack2bf(y[4], y[5]), pack2bf(y[6], y[7])};
      *(uint4*)(dst + 8) = uint4{pack2bf(y[8], y[9]), pack2bf(y[10], y[11]), pack2bf(y[12], y[13]), pack2bf(y[14], y[15])};
    }
  }
  const int vbsel = (otid() >> 8) & 1;
  if ((w >> 1) == vbsel) {
    const int dir = w & 1;
    const int i = dir ? 63 - lane : lane;
    const float* gr = GATES + (size_t)(u0 + i) * 16;
    const float braw = gr[dir * 4 + h], araw = gr[8 + dir * 4 + h];
    const float beta = 1.f / (1.f + __expf(-braw));
    const float xx = araw + p.delta_dt_bias[(l * 2 + dir) * 4 + h];
    const float sp = fmaxf(xx, 0.f) + log1pf(__expf(-fabsf(xx)));
    float gv = -__expf(p.delta_a_log[(l * 2 + dir) * 4 + h]) * sp;
#pragma unroll
    for (int o = 1; o < 64; o <<= 1) {
      const float t = sup(gv, o);
      if (lane >= o) gv += t;
    }
    sGc[dir * 64 + lane] = gv;
    sBeta[dir * 64 + lane] = beta;
  }
  __syncthreads();
  const int dir = w >> 1, half = w & 1;
  const int cid = lat ? 256 + ((bl * 4 + h) * 64 + (dir ? NC - 1 - n : n)) : ((bl * 4 + h) * 4 + (dir ? NC - 1 - n : n));
  u16* dn = (u16*)(p.ws + OFF_DN + (size_t)(dir * 1280 + cid) * 40960);
  u16* dW = dn, *dQG = dn + 4096, *dAQK = dn + 8192, *dKT = dn + 12288, *dU = dn + 16384;
  const float* gc = sGc + dir * 64;
  {
    float* Ld = sL + dir * 4608;
#pragma unroll
    for (int ii = 0; ii < 2; ++ii) {
      const int it = half * 2 + ii;
      const int arow = dir ? 63 - (it * 16 + l15) : it * 16 + l15;
      bf16x8 ak[2], aq[2];
#pragma unroll
      for (int ks = 0; ks < 2; ++ks) {
        ak[ks] = *(const bf16x8*)(sK + arow * 72 + ks * 32 + g * 8);
        aq[ks] = *(const bf16x8*)(sQ + arow * 72 + ks * 32 + g * 8);
      }
#pragma unroll
      for (int jt = 0; jt < 4; ++jt) {
        const int brow = dir ? 63 - (jt * 16 + l15) : jt * 16 + l15;
        f32x4 kk = f32x4{0.f, 0.f, 0.f, 0.f}, qk = f32x4{0.f, 0.f, 0.f, 0.f};
#pragma unroll
        for (int ks = 0; ks < 2; ++ks) {
          const bf16x8 bk = *(const bf16x8*)(sK + brow * 72 + ks * 32 + g * 8);
          kk = MFMA16(ak[ks], bk, kk);
          qk = MFMA16(aq[ks], bk, qk);
        }
        const int jp = jt * 16 + l15;
        const float gj = gc[jp];
#pragma unroll
        for (int rr = 0; rr < 4; ++rr) {
          const int ip = it * 16 + g * 4 + rr;
          const float dec = __expf(fminf(gc[ip] - gj, 0.f));
          Ld[ip * 72 + jp] = (ip > jp) ? sBeta[dir * 64 + ip] * kk[rr] * dec : 0.f;
          dAQK[ip * 64 + jp] = (u16)f2bf((ip >= jp) ? qk[rr] * dec : 0.f);
        }
      }
    }
  }
  {
    const int hd = tid & 127;
    const int ip = hd & 63, dh = hd >> 6;
    const int srow = dir ? 63 - ip : ip;
    const float eg = __expf(gc[ip]);
    const float ef = __expf(gc[63] - gc[ip]);
#pragma unroll
    for (int d8 = 0; d8 < 4; ++d8) {
      float qv[8];
      unpack8(*(const uint4*)(sQ + srow * 72 + dh * 32 + d8 * 8), qv);
      *(uint4*)(dQG + ip * 64 + dh * 32 + d8 * 8) = uint4{pack2bf(qv[0] * eg, qv[1] * eg), pack2bf(qv[2] * eg, qv[3] * eg), pack2bf(qv[4] * eg, qv[5] * eg), pack2bf(qv[6] * eg, qv[7] * eg)};
      float kv[8];
      unpack8(*(const uint4*)(sK + srow * 72 + dh * 32 + d8 * 8), kv);
#pragma unroll
      for (int j = 0; j < 8; ++j) dKT[(dh * 32 + d8 * 8 + j) * 64 + ip] = (u16)f2bf(kv[j] * ef);
    }
    if (hd == 0) ((float*)(p.ws + OFF_GL))[dir * 1280 + cid] = __expf(gc[63]);
  }
  __syncthreads();
  if (half == vbsel) {
    const float* Ld = sL + dir * 4608;
    float T[64];
#pragma unroll
    for (int i = 0; i < 64; ++i) {
      float t = (i == lane) ? 1.f : 0.f, t2 = 0.f;
#pragma unroll
      for (int j4 = 0; j4 < (i + 3) / 4; ++j4) {
        const float4 lv = *(const float4*)(Ld + i * 72 + j4 * 4);
        if (j4 * 4 + 0 < i) t -= lv.x * T[j4 * 4 + 0];
        if (j4 * 4 + 1 < i) t2 -= lv.y * T[j4 * 4 + 1];
        if (j4 * 4 + 2 < i) t -= lv.z * T[j4 * 4 + 2];
        if (j4 * 4 + 3 < i) t2 -= lv.w * T[j4 * 4 + 3];
      }
      T[i] = t + t2;
      if ((i & 3) == 3) __builtin_amdgcn_sched_barrier(0);
    }
    const float bc = sBeta[dir * 64 + lane];
    const float bg = bc * __expf(gc[lane]);
    u16* Tb = (u16*)(sL + dir * 4608);
    u16* Tbg = Tb + 4608;
#pragma unroll
    for (int i = 0; i < 64; ++i) {
      Tb[i * 72 + lane] = (u16)f2bf(T[i] * bc);
      Tbg[i * 72 + lane] = (u16)f2bf(T[i] * bg);
    }
  }
  __syncthreads();
  {
    const u16* Tb = (const u16*)(sL + dir * 4608);
    const u16* Tbg = Tb + 4608;
#pragma unroll
    for (int ii = 0; ii < 2; ++ii) {
      const int pt = half * 2 + ii;
      bf16x8 ab[2], abg[2];
#pragma unroll
      for (int ks = 0; ks < 2; ++ks) {
        ab[ks] = *(const bf16x8*)(Tb + (pt * 16 + l15) * 72 + ks * 32 + g * 8);
        abg[ks] = *(const bf16x8*)(Tbg + (pt * 16 + l15) * 72 + ks * 32 + g * 8);
      }
#pragma unroll
      for (int dt = 0; dt < 4; ++dt) {
        f32x4 uu = f32x4{0.f, 0.f, 0.f, 0.f}, ww = f32x4{0.f, 0.f, 0.f, 0.f};
#pragma unroll
        for (int ks = 0; ks < 2; ++ks) {
          bf16x8 bv, bk;
#pragma unroll
          for (int j = 0; j < 8; ++j) {
            const int jp = ks * 32 + g * 8 + j;
            const int srow = dir ? 63 - jp : jp;
            bv[j] = (short)sV[srow * 72 + dt * 16 + l15];
            bk[j] = (short)sK[srow * 72 + dt * 16 + l15];
          }
          uu = MFMA16(ab[ks], bv, uu);
          ww = MFMA16(abg[ks], bk, ww);
        }
#pragma unroll
        for (int rr = 0; rr < 4; ++rr) {
          const int ip = pt * 16 + g * 4 + rr;
          dU[ip * 64 + dt * 16 + l15] = (u16)f2bf(uu[rr]);
          dW[ip * 64 + dt * 16 + l15] = (u16)f2bf(ww[rr]);
        }
      }
    }
  }
  __syncthreads();
}

DI void fft1_item(char* smem, const Params& p, int r, int item) {
  const int bl = item >> 8, g4 = (item >> 6) & 3, l2 = item & 63;
  const int tid = opaque_tid(), lane = tid & 63, w = tid >> 6, l15 = lane & 15, g = lane >> 4;
  u16* sXc = (u16*)smem; u16* sXs = sXc + 4608; u16* sC = sXs + 4608; u16* sS = sC + 4608;
  const u16* P = (const u16*)(p.ws + OFF_P);
  const u16* CS = (const u16*)(p.ws + OFF_FFT);
  const float* TW = (const float*)(p.ws + OFF_FFT + 16384);
  {
    const int row = tid >> 2, q = tid & 3;
    const u16* src = P + (size_t)(4096 + bl * 4096 + row * 64 + l2) * PW + 2304 + g4 * 64 + q * 16;
    *(uint4*)(sXc + row * 72 + q * 16) = *(const uint4*)src;
    *(uint4*)(sXc + row * 72 + q * 16 + 8) = *(const uint4*)(src + 8);
    *(uint4*)(sXs + row * 72 + q * 16) = *(const uint4*)(src + 256);
    *(uint4*)(sXs + row * 72 + q * 16 + 8) = *(const uint4*)(src + 264);
    *(uint4*)(sC + row * 72 + q * 16) = *(const uint4*)(CS + row * 64 + q * 16);
    *(uint4*)(sC + row * 72 + q * 16 + 8) = *(const uint4*)(CS + row * 64 + q * 16 + 8);
    *(uint4*)(sS + row * 72 + q * 16) = *(const uint4*)(CS + 4096 + row * 64 + q * 16);
    *(uint4*)(sS + row * 72 + q * 16 + 8) = *(const uint4*)(CS + 4096 + row * 64 + q * 16 + 8);
  }
  __syncthreads();
  bf16x8 aC[2], aS[2], aCn[2], aSn[2];
#pragma unroll
  for (int ks = 0; ks < 2; ++ks) {
    aC[ks] = *(const bf16x8*)(sC + (w * 16 + l15) * 72 + ks * 32 + g * 8);
    aS[ks] = *(const bf16x8*)(sS + (w * 16 + l15) * 72 + ks * 32 + g * 8);
#pragma unroll
    for (int j = 0; j < 8; ++j) { aCn[ks][j] = (short)(aC[ks][j] ^ (short)0x8000); aSn[ks][j] = (short)(aS[ks][j] ^ (short)0x8000); }
  }
  u16* Z1 = (u16*)(p.ws + OFF_XTL);
#pragma unroll
  for (int kt = 0; kt < 4; ++kt) {
    f32x4 accR = f32x4{0.f, 0.f, 0.f, 0.f}, accI = f32x4{0.f, 0.f, 0.f, 0.f};
#pragma unroll
    for (int ks = 0; ks < 2; ++ks) {
      bf16x8 bc, bs;
#pragma unroll
      for (int j = 0; j < 8; ++j) {
        bc[j] = (short)sXc[(ks * 32 + g * 8 + j) * 72 + kt * 16 + l15];
        bs[j] = (short)sXs[(ks * 32 + g * 8 + j) * 72 + kt * 16 + l15];
      }
      accR = MFMA16(aC[ks], bc, accR);
      accR = MFMA16(aSn[ks], bs, accR);
      accI = MFMA16(aCn[ks], bs, accI);
      accI = MFMA16(aSn[ks], bc, accI);
    }
#pragma unroll
    for (int rr = 0; rr < 4; ++rr) {
      const int k1 = w * 16 + g * 4 + rr;
      const float c = TW[(k1 * 64 + l2) * 2], s = TW[(k1 * 64 + l2) * 2 + 1];
      const float zr = accR[rr] * c + accI[rr] * s;
      const float zi = accI[rr] * c - accR[rr] * s;
      const size_t base = ((size_t)(((bl * 4 + g4) * 64 + k1) * 64 + l2) * 2) * 64 + kt * 16 + l15;
      Z1[base] = (u16)f2bf(zr);
      Z1[base + 64] = (u16)f2bf(zi);
    }
  }
  __syncthreads();
}
DI void fft2_item(char* smem, const Params& p, int r, int item) {
  const int bl = item >> 8, g4 = (item >> 6) & 3, k1 = item & 63;
  const int tid = opaque_tid(), lane = tid & 63, w = tid >> 6, l15 = lane & 15, g = lane >> 4;
  u16* sZr = (u16*)smem; u16* sZi = sZr + 4608; u16* sC = sZi + 4608; u16* sS = sC + 4608;
  const u16* CS = (const u16*)(p.ws + OFF_FFT);
  const u16* Z1 = (const u16*)(p.ws + OFF_XTL) + (size_t)(((bl * 4 + g4) * 64 + k1) * 64) * 128;
  {
    const int row = tid >> 2, q = tid & 3;
    const u16* src = Z1 + row * 128 + q * 16;
    *(uint4*)(sZr + row * 72 + q * 16) = *(const uint4*)src;
    *(uint4*)(sZr + row * 72 + q * 16 + 8) = *(const uint4*)(src + 8);
    *(uint4*)(sZi + row * 72 + q * 16) = *(const uint4*)(src + 64);
    *(uint4*)(sZi + row * 72 + q * 16 + 8) = *(const uint4*)(src + 72);
    *(uint4*)(sC + row * 72 + q * 16) = *(const uint4*)(CS + row * 64 + q * 16);
    *(uint4*)(sC + row * 72 + q * 16 + 8) = *(const uint4*)(CS + row * 64 + q * 16 + 8);
    *(uint4*)(sS + row * 72 + q * 16) = *(const uint4*)(CS + 4096 + row * 64 + q * 16);
    *(uint4*)(sS + row * 72 + q * 16 + 8) = *(const uint4*)(CS + 4096 + row * 64 + q * 16 + 8);
  }
  __syncthreads();
  bf16x8 aC[2], aS[2];
#pragma unroll
  for (int ks = 0; ks < 2; ++ks) {
    aC[ks] = *(const bf16x8*)(sC + (w * 16 + l15) * 72 + ks * 32 + g * 8);
    aS[ks] = *(const bf16x8*)(sS + (w * 16 + l15) * 72 + ks * 32 + g * 8);
  }
  u16* M = (u16*)(p.ws + OFF_H);
#pragma unroll
  for (int kt = 0; kt < 4; ++kt) {
    f32x4 acc = f32x4{0.f, 0.f, 0.f, 0.f};
#pragma unroll
    for (int ks = 0; ks < 2; ++ks) {
      bf16x8 br, bi;
#pragma unroll
      for (int j = 0; j < 8; ++j) {
        br[j] = (short)sZr[(ks * 32 + g * 8 + j) * 72 + kt * 16 + l15];
        bi[j] = (short)sZi[(ks * 32 + g * 8 + j) * 72 + kt * 16 + l15];
      }
      acc = MFMA16(aC[ks], br, acc);
      acc = MFMA16(aS[ks], bi, acc);
    }
#pragma unroll
    for (int rr = 0; rr < 4; ++rr) {
      const int k2 = w * 16 + g * 4 + rr;
      const int u = 4096 + bl * 4096 + k1 + 64 * k2;
      M[(size_t)grow_of(u, r) * 1024 + 768 + g4 * 64 + kt * 16 + l15] = (u16)f2bf(acc[rr] * (1.f / 512.f));
    }
  }
  __syncthreads();
}

DI void phase_prep(char* smem0, const Params& p, int l, int r, int bid0, int nb0) {
  const int vb = otid() >> 8;
  char* smem = smem0 + vb * VSM;
  int* ctr = (int*)(p.ws + OFF_CTR) + 16 + l * 2 + r;
  volatile int* slot = (volatile int*)(smem0 + 2 * VSM);
  for (;;) {
    __syncthreads();
    if (otid() == 0) *slot = atomicAdd(ctr, 1);
    __syncthreads();
    const int pair = *slot;
    if (pair >= 2624) break;
    const int it = pair * 2 + vb;
    if (it < 1280) prep_delta_item(smem, p, l, r, it);
    else if (it < 1600) prep_attn_item(p, l, r, it - 1280);
    else if (it < 1664) prep_cache_item(p, l, r, it - 1600);
    else if (it < 4224) prep_convb_item(p, l, r, it - 1664);
    else fft1_item(smem, p, r, it - 4224);
  }
}

DI void scan_item(char* smem, const Params& p, int l, int r, int dir, bool lat, int chain) {
  const int bl = chain >> 2, h = chain & 3;
  const int NC = lat ? 64 : 4;
  const int tid = opaque_tid(), lane = tid & 63, w = tid >> 6, l15 = lane & 15, g = lane >> 4;
  u16* sW = (u16*)smem;
  u16* sQG = sW + 4608, *sAQK = sW + 9216, *sKT = sW + 13824, *sU = sW + 18432;
  const int cid0 = lat ? 256 + chain * 64 : chain * 4;
  const char* dnbase = p.ws + OFF_DN + (size_t)(dir * 1280 + cid0) * 40960;
  const float* GL = (const float*)(p.ws + OFF_GL) + dir * 1280 + cid0;
  u16* O = (u16*)(p.ws + OFF_ODIR) + (size_t)dir * TR * 256;
  const int useq = lat ? 4096 + bl * 4096 : bl * 256;
  const int dv = w * 16 + l15;
  f32x4 S[4];
  if (lat) {
    const int b = r * 4 + bl;
    const float* s0 = p.state_delta + (size_t)(((b * 2 + l) * 2 + dir) * 4 + h) * 4096;
#pragma unroll
    for (int t = 0; t < 4; ++t)
#pragma unroll
      for (int rr = 0; rr < 4; ++rr) S[t][rr] = s0[(t * 16 + g * 4 + rr) * 64 + dv];
  } else {
#pragma unroll
    for (int t = 0; t < 4; ++t) S[t] = f32x4{0.f, 0.f, 0.f, 0.f};
  }
#define REP10(X) X(0) X(1) X(2) X(3) X(4) X(5) X(6) X(7) X(8) X(9)
#define PRE_DECL(i) uint4 pre##i = *(const uint4*)(dnbase + (size_t)(tid + i * 256) * 16);
  REP10(PRE_DECL)
  float gl = GL[0];
  for (int n = 0; n < NC; ++n) {
    __syncthreads();
#define PRE_ST(i) { const int c = tid + i * 256; const int mat = c >> 9, row = (c >> 3) & 63, kc = c & 7; *(uint4*)(sW + mat * 4608 + row * 72 + kc * 8) = pre##i; }
    REP10(PRE_ST)
    const float glc = gl;
    __syncthreads();
    if (n + 1 < NC) {
      const char* nb_ = dnbase + (size_t)(n + 1) * 40960;
#define PRE_LD(i) pre##i = *(const uint4*)(nb_ + (size_t)(tid + i * 256) * 16);
      REP10(PRE_LD)
      gl = GL[n + 1];
    }
    bf16x8 Sb[2], Sn[2];
#pragma unroll
    for (int ks = 0; ks < 2; ++ks) {
      Sb[ks] = pack8(S[2 * ks], S[2 * ks + 1]);
#pragma unroll
      for (int j = 0; j < 8; ++j) Sn[ks][j] = (short)(Sb[ks][j] ^ (short)0x8000);
    }
    f32x4 vn[4];
#pragma unroll
    for (int pt = 0; pt < 4; ++pt) {
#pragma unroll
      for (int rr = 0; rr < 4; ++rr) vn[pt][rr] = bf2f(sU[(pt * 16 + g * 4 + rr) * 72 + dv]);
#pragma unroll
      for (int ks = 0; ks < 2; ++ks) vn[pt] = MFMA16(frag_perm(sW, pt * 16 + l15, ks, g), Sn[ks], vn[pt]);
      __builtin_amdgcn_sched_barrier(0);
    }
    __builtin_amdgcn_sched_barrier(0);
    bf16x8 Vb[2];
#pragma unroll
    for (int ks = 0; ks < 2; ++ks) Vb[ks] = pack8(vn[2 * ks], vn[2 * ks + 1]);
    const int norig = dir ? NC - 1 - n : n;
#pragma unroll
    for (int pt = 0; pt < 4; ++pt) {
      f32x4 o = f32x4{0.f, 0.f, 0.f, 0.f};
#pragma unroll
      for (int ks = 0; ks < 2; ++ks) {
        o = MFMA16(frag_perm(sQG, pt * 16 + l15, ks, g), Sb[ks], o);
        o = MFMA16(frag_perm(sAQK, pt * 16 + l15, ks, g), Vb[ks], o);
      }
#pragma unroll
      for (int rr = 0; rr < 4; ++rr) {
        const int ip = pt * 16 + g * 4 + rr;
        const int i = dir ? 63 - ip : ip;
        O[(size_t)(useq + norig * 64 + i) * 256 + h * 64 + dv] = (u16)f2bf(o[rr]);
      }
      __builtin_amdgcn_sched_barrier(0);
    }
#pragma unroll
    for (int t = 0; t < 4; ++t) {
      S[t] = S[t] * glc;
#pragma unroll
      for (int ks = 0; ks < 2; ++ks) S[t] = MFMA16(frag_perm(sKT, t * 16 + l15, ks, g), Vb[ks], S[t]);
    }
  }
  if (!lat) {
    const int b = r * 16 + bl;
    float* so = p.out + OUT_S + (size_t)(((b * 2 + l) * 2 + dir) * 4 + h) * 4096;
#pragma unroll
    for (int t = 0; t < 4; ++t)
#pragma unroll
      for (int rr = 0; rr < 4; ++rr) so[(t * 16 + g * 4 + rr) * 64 + dv] = S[t][rr];
  }
  __syncthreads();
}

template <int QT>
DI void attn_item(char* smem, const Params& p, int r, bool lat, int bl, int hq, int q0) {
  const int kvh = hq >> 1;
  const int Lk = lat ? 4608 : 256;
  const int useq = lat ? 4096 + bl * 4096 : bl * 256;
  const u16* Kb = lat ? (const u16*)(p.ws + OFF_KBL) + (size_t)(bl * 2 + kvh) * 4608 * 64 : (const u16*)(p.ws + OFF_KBC) + (size_t)(bl * 2 + kvh) * 256 * 64;
  const u16* Vt = lat ? (const u16*)(p.ws + OFF_VTL) + (size_t)(bl * 2 + kvh) * 64 * 4608 : (const u16*)(p.ws + OFF_VTC) + (size_t)(bl * 2 + kvh) * 64 * 256;
  const u16* Qb = (const u16*)(p.ws + OFF_QB);
  const int tid = opaque_tid(), lane = tid & 63, w = tid >> 6, l15 = lane & 15, g = lane >> 4;
  u16* sK = (u16*)smem;
  u16* sV = (u16*)(smem + 18432);
  const int uq0 = useq + q0 + w * (16 * QT);
  bf16x8 qf[QT][2];
#pragma unroll
  for (int qt = 0; qt < QT; ++qt)
#pragma unroll
    for (int ks = 0; ks < 2; ++ks) qf[qt][ks] = *(const bf16x8*)(Qb + ((size_t)(uq0 + qt * 16 + l15) * 4 + hq) * 64 + ks * 32 + g * 8);
  f32x4 oacc[4][QT];
#pragma unroll
  for (int dt = 0; dt < 4; ++dt)
#pragma unroll
    for (int qt = 0; qt < QT; ++qt) oacc[dt][qt] = f32x4{0.f, 0.f, 0.f, 0.f};
  float mrun[QT], lrun[QT];
#pragma unroll
  for (int qt = 0; qt < QT; ++qt) { mrun[qt] = -1e30f; lrun[qt] = 0.f; }
  const int NT = Lk >> 6;
#define REP4(X) X(0) X(1) X(2) X(3)
  uint4 apre0, apre1, apre2, apre3;
#define AT_LD(i) { const int c = tid + i * 256; const int row = (c >> 3) & 63, kc = c & 7; \
    apre##i = (c < 512) ? *(const uint4*)(Kb + (size_t)(kt_ * 64 + row) * 64 + kc * 8) : *(const uint4*)(Vt + (size_t)row * Lk + kt_ * 64 + kc * 8); }
#define AT_ST(i) { const int c = tid + i * 256; const int row = (c >> 3) & 63, kc = c & 7; \
    *(uint4*)((c < 512 ? sK : sV) + buf_ * 4608 + row * 72 + kc * 8) = apre##i; }
#define gload(kt) { const int kt_ = (kt); REP4(AT_LD) }
#define sstore(b) { const int buf_ = (b); REP4(AT_ST) }
  gload(0)
  sstore(0)
  __syncthreads();
  for (int kt = 0; kt < NT; ++kt) {
    const int buf = kt & 1;
    if (kt + 1 < NT) gload(kt + 1)
    const u16* cK = sK + buf * 4608;
    const u16* cV = sV + buf * 4608;
    f32x4 sacc[4][QT];
#pragma unroll
    for (int k4 = 0; k4 < 4; ++k4) {
      bf16x8 kf[2];
#pragma unroll
      for (int ks = 0; ks < 2; ++ks) kf[ks] = *(const bf16x8*)(cK + (k4 * 16 + l15) * 72 + ks * 32 + g * 8);
#pragma unroll
      for (int qt = 0; qt < QT; ++qt) {
        f32x4 a = f32x4{0.f, 0.f, 0.f, 0.f};
        a = MFMA16(kf[0], qf[qt][0], a);
        a = MFMA16(kf[1], qf[qt][1], a);
        sacc[k4][qt] = a;
      }
    }
    bf16x8 pb[QT][2];
    float mxl[QT];
#pragma unroll
    for (int qt = 0; qt < QT; ++qt) {
      float mx = sacc[0][qt][0];
#pragma unroll
      for (int k4 = 0; k4 < 4; ++k4)
#pragma unroll
        for (int rr = 0; rr < 4; ++rr) mx = fmaxf(mx, sacc[k4][qt][rr]);
      mxl[qt] = mx;
    }
    bool need = false;
#pragma unroll
    for (int qt = 0; qt < QT; ++qt) need = need || (mxl[qt] > mrun[qt] + 8.f);
    if (__builtin_amdgcn_ballot_w64(need) != 0ull) {
#pragma unroll
      for (int qt = 0; qt < QT; ++qt) {
        float mx = mxl[qt];
        mx = fmaxf(mx, sx(mx, 16));
        mx = fmaxf(mx, sx(mx, 32));
        const float mnew = fmaxf(mrun[qt], mx);
        const float alpha = __builtin_amdgcn_exp2f(mrun[qt] - mnew);
        mrun[qt] = mnew;
        lrun[qt] *= alpha;
#pragma unroll
        for (int dt = 0; dt < 4; ++dt) oacc[dt][qt] = oacc[dt][qt] * alpha;
      }
    }
#pragma unroll
    for (int qt = 0; qt < QT; ++qt) {
      const float mref = mrun[qt];
      float ps = 0.f;
#pragma unroll
      for (int k4 = 0; k4 < 4; ++k4)
#pragma unroll
        for (int rr = 0; rr < 4; ++rr) {
          const float e = __builtin_amdgcn_exp2f(sacc[k4][qt][rr] - mref);
          sacc[k4][qt][rr] = e;
          ps += e;
        }
      lrun[qt] += ps;
      pb[qt][0] = pack8(sacc[0][qt], sacc[1][qt]);
      pb[qt][1] = pack8(sacc[2][qt], sacc[3][qt]);
    }
#pragma unroll
    for (int dt = 0; dt < 4; ++dt)
#pragma unroll
      for (int ks = 0; ks < 2; ++ks) {
        const bf16x8 vf = frag_perm(cV, dt * 16 + l15, ks, g);
#pragma unroll
        for (int qt = 0; qt < QT; ++qt) oacc[dt][qt] = MFMA16(vf, pb[qt][ks], oacc[dt][qt]);
      }
    if (kt + 1 < NT) sstore(buf ^ 1)
    __syncthreads();
  }
  u16* M = (u16*)(p.ws + OFF_H);
#pragma unroll
  for (int qt = 0; qt < QT; ++qt) {
    float lt = lrun[qt];
    lt += sx(lt, 16);
    lt += sx(lt, 32);
    const float inv = 1.f / lt;
    const int u = uq0 + qt * 16 + l15;
    u16* dst = M + (size_t)grow_of(u, r) * 1024 + hq * 64 + g * 4;
#pragma unroll
    for (int dt = 0; dt < 4; ++dt) {
      const f32x4 o = oacc[dt][qt];
      *(uint2*)(dst + dt * 16) = uint2{pack2bf(o[0] * inv, o[1] * inv), pack2bf(o[2] * inv, o[3] * inv)};
    }
  }
}

DI void phase_mix(char* smem0, const Params& p, int l, int ra, int bid0, int nb0) {
  const int r = ra & 1;
  {
    pg8::Gemm g{(const u16*)(p.ws + OFF_DFTC), (const u16*)(p.ws + OFF_XTC), 256, 4096, 512, 512};
    OrderOne S{bid0, 16, 1};
    EpiFourier E{(u16*)(p.ws + OFF_H), r, 0, 1.f / 128.f};
    pg8::gemm_phase<EpiFourier, OrderOne, false>((PG8_LAS unsigned char*)smem0, g, S, E, nullptr);
  }
  const int vb = otid() >> 8;
  char* smem = smem0 + vb * VSM;
  int* ctr = (int*)(p.ws + OFF_CTR) + l * 2 + r + 4 * (ra >> 1);
  volatile int* slot = (volatile int*)(smem0 + 2 * VSM);
  for (;;) {
    __syncthreads();
    if (otid() == 0) *slot = atomicAdd(ctr, 1);
    __syncthreads();
    const int pair = *slot;
    if (pair >= 928) break;
    const int it = pair * 2 + vb;
    if (it < 32) scan_item(smem, p, l, r, it >> 4, true, it & 15);
    else if (it < 512) { const int j = it - 32; attn_item<2>(smem, p, r, true, j / 120, (j / 30) & 3, (j % 30) * 128); }
    else if (it < 576) { const int j = it - 512; attn_item<1>(smem, p, r, true, j >> 4, (j >> 2) & 3, 3840 + (j & 3) * 64); }
    else if (it < 1600) fft2_item(smem, p, r, it - 576);
    else if (it < 1728) { const int j = it - 1600; scan_item(smem, p, l, r, j >> 6, false, j & 63); }
    else { const int j = it - 1728; attn_item<2>(smem, p, r, false, j >> 3, (j >> 1) & 3, (j & 1) * 128); }
  }
}

DI void phase_post(const Params& p, int l, int r, int bid, int nb) {
  const u16* O0 = (const u16*)(p.ws + OFF_ODIR);
  const u16* O1 = O0 + (size_t)TR * 256;
  const u16* P = (const u16*)(p.ws + OFF_P);
  u16* M = (u16*)(p.ws + OFF_H);
  for (int it = bid * 2 + (otid() >> 8); it < TR * 16 / 256; it += nb * 2) {
    const int idx = it * 256 + (otid() & 255);
    const int u = idx >> 4, h = (idx >> 2) & 3, q4 = idx & 3;
    const int c0 = h * 64 + q4 * 16;
    float a[16], b[16], z[16];
    unpack8(*(const uint4*)(O0 + (size_t)u * 256 + c0), a);
    unpack8(*(const uint4*)(O0 + (size_t)u * 256 + c0 + 8), a + 8);
    unpack8(*(const uint4*)(O1 + (size_t)u * 256 + c0), b);
    unpack8(*(const uint4*)(O1 + (size_t)u * 256 + c0 + 8), b + 8);
    unpack8(*(const uint4*)(P + (size_t)u * PW + 2048 + c0), z);
    unpack8(*(const uint4*)(P + (size_t)u * PW + 2048 + c0 + 8), z + 8);
    float ss = 0.f;
#pragma unroll
    for (int j = 0; j < 16; ++j) { a[j] += b[j]; ss += a[j] * a[j]; }
    ss += sx(ss, 1);
    ss += sx(ss, 2);
    const float rstd = rsqrtf(ss * (1.f / 64.f) + 1e-6f);
    float o[16];
#pragma unroll
    for (int j = 0; j < 16; ++j) o[j] = a[j] * rstd * p.delta_norm[l * 64 + q4 * 16 + j] * siluf(z[j]);
    u16* dst = M + (size_t)grow_of(u, r) * 1024 + 512 + c0;
    *(uint4*)dst = uint4{pack2bf(o[0], o[1]), pack2bf(o[2], o[3]), pack2bf(o[4], o[5]), pack2bf(o[6], o[7])};
    *(uint4*)(dst + 8) = uint4{pack2bf(o[8], o[9]), pack2bf(o[10], o[11]), pack2bf(o[12], o[13]), pack2bf(o[14], o[15])};
  }
}

#define XB_TMO      128
#define XB_XCNT(j)  (256  + 64 * (j))
#define XB_XSUB(j)  (1280 + 64 * (j))
#define XB_XGEN(j)  (2304 + 64 * (j))
#define XB_TOP      3328
#define XB_TOPGEN   3392
#define XCD_BAR_WORDS 3456
#define XB_SPIN_CAP (1u << 22)
#define LAS __attribute__((address_space(3)))

__device__ __forceinline__ unsigned xb_ld(unsigned* p)              { return __hip_atomic_load(p, __ATOMIC_RELAXED, __HIP_MEMORY_SCOPE_AGENT); }
__device__ __forceinline__ unsigned xb_add(unsigned* p, unsigned v) { return __hip_atomic_fetch_add(p, v, __ATOMIC_RELAXED, __HIP_MEMORY_SCOPE_AGENT); }
__device__ __forceinline__ unsigned xb_xcc_id() { return (unsigned)__builtin_amdgcn_s_getreg((3 << 11) | 20) & 0xFu; }
#define XB_SPIN(cond, bar) do { unsigned _sp = 0; while (cond) { __builtin_amdgcn_s_sleep(1); \
    if ((++_sp & 255u) == 0u) { if (xb_ld(&(bar)[XB_TMO])) break; if (_sp > XB_SPIN_CAP) { atomicAdd(&(bar)[XB_TMO], 1u); break; } } } } while (0)

struct XcdBarrier {
    unsigned* bar; unsigned x;
    volatile LAS unsigned* st;
};

__device__ __forceinline__ XcdBarrier xcd_barrier_post(unsigned* bar, volatile LAS unsigned* st) {
    XcdBarrier b; b.bar = bar; b.x = xb_xcc_id(); b.st = st;
    if (threadIdx.x == 0) (void)xb_add(&bar[XB_XCNT(b.x)], 1u);
    return b;
}
__device__ __forceinline__ void xcd_barrier_complete(unsigned* bar, unsigned x, unsigned& nloc, unsigned& nx) {
    const unsigned G = gridDim.x * gridDim.y * gridDim.z;
    unsigned sum, cnt, mine, sp = 0u;
    for (;;) {
        sum = 0u; cnt = 0u; mine = 0u;
#pragma unroll
        for (unsigned j = 0; j < 16; ++j) { const unsigned c = xb_ld(&bar[XB_XCNT(j)]); sum += c; cnt += (c > 0u) ? 1u : 0u; mine = (j == x) ? c : mine; }
        if (sum == G) break;
        __builtin_amdgcn_s_sleep(1);
        if ((++sp & 255u) == 0u) { if (xb_ld(&bar[XB_TMO])) break; if (sp > XB_SPIN_CAP) { atomicAdd(&bar[XB_TMO], 1u); break; } }
    }
    nloc = mine > 0u ? mine : 1u; nx = cnt > 0u ? cnt : 1u;
}

__device__ __forceinline__ void xcd_barrier(const XcdBarrier& b) {
    asm volatile("s_waitcnt vmcnt(0)" ::: "memory");
    __syncthreads();
    if (threadIdx.x == 0) {
        unsigned* bar = b.bar;
        __builtin_amdgcn_s_waitcnt(0);
        unsigned nloc = b.st[0], nx = b.st[1];
        if (nloc == 0u) { xcd_barrier_complete(bar, b.x, nloc, nx); b.st[0] = nloc; b.st[1] = nx; }
        const unsigned old = xb_add(&bar[XB_XSUB(b.x)], 1u);
        const unsigned gen = old / nloc;
        if (old + 1u == (gen + 1u) * nloc) {
            __builtin_amdgcn_fence(__ATOMIC_RELEASE, "agent");
            asm volatile("s_waitcnt vmcnt(0)" ::: "memory");
            const unsigned og = xb_add(&bar[XB_TOP], 1u);
            const unsigned tg = og / nx;
            if (og + 1u == (tg + 1u) * nx) xb_add(&bar[XB_TOPGEN], 1u);
            else XB_SPIN(xb_ld(&bar[XB_TOPGEN]) == tg, bar);
            __builtin_amdgcn_fence(__ATOMIC_ACQUIRE, "agent");
            xb_add(&bar[XB_XGEN(b.x)], 1u);
            asm volatile("s_waitcnt vmcnt(0)" ::: "memory");
        } else {
            XB_SPIN(xb_ld(&bar[XB_XGEN(b.x)]) == gen, bar);
            __builtin_amdgcn_fence(__ATOMIC_ACQUIRE, "agent");
            asm volatile("s_waitcnt vmcnt(0)" ::: "memory");
        }
    }
    __syncthreads();
}


DI void run_phase(char* smem, const Params& p0, int ph, int l, int a, int bid, int nb) {
  Params p = p0;
  { char* w_ = p.ws; asm volatile("" : "+s"(w_)); p.ws = w_; float* o_ = p.out; asm volatile("" : "+s"(o_)); p.out = o_; }
  asm volatile("" : "+s"(bid));
  asm volatile("" : "+s"(nb));
  switch (ph) {
    case 0: phase_init(smem, p, bid, nb); break;
    case 1: phase_norm(p, l, a, bid, nb); break;
    case 2: phase_up(smem, p, l, a, bid, nb); break;
    case 3: phase_resid(smem, p, (const u16*)(p.ws + OFF_ACT), (const u16*)(p.ws + OFF_DNT + (size_t)(l * 2 + a) * SZ_DNT), 2816, l, a ? 8 : 2, 0.5f, l == 0 && a == 0, bid, nb); break;
    case 4: phase_proj(smem, p, l, a, bid, nb); break;
    case 5: phase_prep(smem, p, l, a, bid, nb); break;
    case 6: phase_mix(smem, p, l, a, bid, nb); break;
    case 7: phase_post(p, l, a, bid, nb); break;
    case 8: phase_resid(smem, p, (const u16*)(p.ws + OFF_H), (const u16*)(p.ws + OFF_OUTT + (size_t)l * SZ_OUTT), 1024, l, 5, 1.f, false, bid, nb); break;
    default: phase_final(p, bid, nb); break;
  }
}

struct Step { int ph, l, a; };
__host__ __device__ inline int build_program(Step* s) {
  int n = 0;
  auto add = [&](int ph, int l, int a) { if (s) { s[n].ph = ph; s[n].l = l; s[n].a = a; } ++n; };
  add(0, 0, 0);
  for (int l = 0; l < 2; ++l) {
    add(1, l, 0); add(2, l, 0); add(3, l, 0);
    add(1, l, 1);
    for (int r = 0; r < 2; ++r) { add(4, l, r); add(5, l, r); add(6, l, r); add(7, l, r); }
    add(8, l, 0);
    add(1, l, 2); add(2, l, 1); add(3, l, 1);
  }
  add(9, 0, 0);
  return n;
}

template <int PH>
__global__ void __launch_bounds__(512, 2) k_phase(Params p, int l, int a) {
  extern __shared__ __attribute__((aligned(16))) char smem[];
  if (a == 0) run_phase(smem, p, PH, l, 0, blockIdx.x, gridDim.x);
  else if (a == 1) run_phase(smem, p, PH, l, 1, blockIdx.x, gridDim.x);
  else run_phase(smem, p, PH, l, 2, blockIdx.x, gridDim.x);
}
typedef void (*phase_fn)(Params, int, int);
static phase_fn phase_table[10] = {k_phase<0>, k_phase<1>, k_phase<2>, k_phase<3>, k_phase<4>, k_phase<5>, k_phase<6>, k_phase<7>, k_phase<8>, k_phase<9>};

__global__ void __launch_bounds__(512, 2) k_mega(Params p) {
  extern __shared__ __attribute__((aligned(16))) char smem[];
  cg::grid_group grid = cg::this_grid();
  const int bid = blockIdx.x, nb = gridDim.x;
  volatile LAS unsigned* st = (volatile LAS unsigned*)(smem + 2 * VSM + 16);
  if (threadIdx.x == 0) { st[0] = 0u; st[1] = 0u; }
  run_phase(smem, p, 0, 0, 0, bid, nb);
  grid.sync();
  const XcdBarrier xb = xcd_barrier_post((unsigned*)(p.ws + OFF_BAR), st);
#define GSYNC() xcd_barrier(xb)
  for (int l = 0; l < 2; ++l) {
    run_phase(smem, p, 1, l, 0, bid, nb); GSYNC();
    run_phase(smem, p, 2, l, 0, bid, nb); GSYNC();
    run_phase(smem, p, 3, l, 0, bid, nb); GSYNC();
    run_phase(smem, p, 1, l, 1, bid, nb); GSYNC();
    for (int r = 0; r < 2; ++r) {
      run_phase(smem, p, 4, l, r, bid, nb); GSYNC();
      run_phase(smem, p, 5, l, r, bid, nb); GSYNC();
      run_phase(smem, p, 6, l, r, bid, nb); GSYNC();
      run_phase(smem, p, 7, l, r, bid, nb); GSYNC();
    }
    run_phase(smem, p, 8, l, 0, bid, nb); GSYNC();
    run_phase(smem, p, 1, l, 2, bid, nb); GSYNC();
    run_phase(smem, p, 2, l, 1, bid, nb); GSYNC();
    run_phase(smem, p, 3, l, 1, bid, nb); GSYNC();
  }
  run_phase(smem, p, 9, 0, 0, bid, nb);
}

extern "C" void kernel_launch(void* const* d_in, const int* in_sizes, int n_in, void* d_out, int out_size, void* d_ws, size_t ws_size, hipStream_t stream) {
  static int grid_blocks = 0;
  if (grid_blocks == 0) {
    if (ws_size < WS_END) { fprintf(stderr, "kernel_launch: workspace too small: %zu < %zu\n", ws_size, (size_t)WS_END); grid_blocks = -1; return; }
    int dev = 0, cus = 0, per_cu = 0;
    hipGetDevice(&dev);
    hipDeviceGetAttribute(&cus, hipDeviceAttributeMultiprocessorCount, dev);
    hipFuncSetAttribute((const void*)k_mega, hipFuncAttributeMaxDynamicSharedMemorySize, LDS_BYTES);
    for (int i = 0; i < 10; ++i) hipFuncSetAttribute((const void*)phase_table[i], hipFuncAttributeMaxDynamicSharedMemorySize, LDS_BYTES);
    hipOccupancyMaxActiveBlocksPerMultiprocessor(&per_cu, (const void*)k_mega, 512, LDS_BYTES);
    if (per_cu < 1) per_cu = 1;
    if (per_cu > 1) per_cu = 1;
    grid_blocks = cus * per_cu;
  }
  if (grid_blocks < 0) return;
  Params p{};
  const float** pf = (const float**)&p;
  for (int i = 0; i < 28; ++i) pf[i] = (const float*)d_in[i];
  p.out = (float*)d_out;
  p.ws = (char*)d_ws;
#if MULTI_LAUNCH
  Step prog[64];
  const int n = build_program(prog);
  for (int i = 0; i < n; ++i) hipLaunchKernelGGL(phase_table[prog[i].ph], dim3(grid_blocks), dim3(512), LDS_BYTES, stream, p, prog[i].l, prog[i].a);
#else
  void* args[] = {&p};
  hipError_t e = hipLaunchCooperativeKernel((const void*)k_mega, dim3(grid_blocks), dim3(512), args, LDS_BYTES, stream);
  if (e != hipSuccess) fprintf(stderr, "cooperative launch failed: %s (grid %d)\n", hipGetErrorString(e), grid_blocks);
#endif
}
```
